# Optimizing an MI355X kernel written in HIP

```python
import jax, jax.numpy as jnp
from jax import lax
import numpy as np

D_MODEL = 1024
BATCH = 8
SEQ = 2048
DEPTH = 4
DEC_BATCH = 8
DEC_SEQ = 16
PAST_LEN = 2048

CHUNK = 64
HEAD_DIM = 64
EPS = 1e-6
A_HEADS = 8
A_WIDTH = A_HEADS * HEAD_DIM
SB_BLOCK = 128
B_HEADS = 4
B_DK = 64
B_DV = 128
B_KW = B_HEADS * B_DK
B_VW = B_HEADS * B_DV
B_GATE_RANK = 16
B_GATE_TEMP = 16.0
GLA_CHUNK = 64
C_HEADS = 16
C_WIDTH = C_HEADS * HEAD_DIM
C_LEFT_CHUNKS = 8
C_WINDOW = C_LEFT_CHUNKS * CHUNK
REL_MIN = -(CHUNK - 1)
REL_MAX = 128
N_REL = REL_MAX - REL_MIN + 1
D_FF = -(-8 * D_MODEL // (3 * 256)) * 256
N_AB = (DEPTH + 1) // 2
N_C = DEPTH // 2
AB_IN = 3 * A_WIDTH + 2 * B_KW + B_VW + B_GATE_RANK + B_VW
AB_OUT = A_WIDTH + B_VW

kernel_name = "hybrid_stickbreak_gla_chunkband_stream_step"


def _rmsnorm(x, g):
    xf = x.astype(jnp.float32)
    y = xf * lax.rsqrt(jnp.mean(xf * xf, axis=-1, keepdims=True) + EPS)
    return (y * g.astype(jnp.float32)).astype(x.dtype)


def _split_cols(z, sizes):
    out, start = [], 0
    for s in sizes:
        out.append(z[..., start:start + s])
        start += s
    return out


def _swiglu(h, wg, wu, wd):
    return (jax.nn.silu(h @ wg) * (h @ wu)) @ wd


def _sb_block(q, k, v, q_pos, k_pos):
    z = jnp.einsum('bthd,bshd->bhts', q, k).astype(jnp.float32) * (HEAD_DIM ** -0.5)
    mask = k_pos[None, :] < q_pos[:, None]
    log_beta = jax.nn.log_sigmoid(z)
    log_keep = jnp.where(mask, jax.nn.log_sigmoid(-z), 0.0)
    rev = lax.cumsum(log_keep, axis=3, reverse=True)
    after = jnp.concatenate([rev[..., 1:], jnp.zeros_like(rev[..., :1])], axis=-1)
    w = jnp.where(mask, jnp.exp(log_beta + after), 0.0)
    return jnp.einsum('bhts,bshd->bthd', w.astype(v.dtype), v)


def _sb_prompt(q, k, v):
    B, S, H, d = q.shape
    nb = S // SB_BLOCK
    qb = jnp.moveaxis(q.reshape(B, nb, SB_BLOCK, H, d), 1, 0)
    pos = jnp.arange(S, dtype=jnp.int32)
    pb = pos.reshape(nb, SB_BLOCK)
    out = lax.map(lambda a: _sb_block(a[0], k, v, a[1], pos), (qb, pb))
    return jnp.moveaxis(out, 0, 1).reshape(B, S, H, d)


def _gla(q, k, v, log_a, s0, L):
    B, T, H, dk = q.shape
    n = T // L

    def chunks(t):
        return jnp.moveaxis(t.astype(jnp.float32).reshape(B, n, L, H, t.shape[-1]), 1, 0)

    qc = chunks(q) * (dk ** -0.5)
    kc, vc, gc = chunks(k), chunks(v), chunks(log_a)
    causal = jnp.tril(jnp.ones((L, L), dtype=bool))

    def step(S, inp):
        qi, ki, vi, gi = inp
        b = jnp.cumsum(gi, axis=1)
        b_last = b[:, -1]
        qg = qi * jnp.exp(b)
        kg = ki * jnp.exp(-b)
        att = jnp.where(causal, jnp.einsum('bthd,bshd->bhts', qg, kg), 0.0)
        o = jnp.einsum('bhts,bshv->bthv', att, vi) + jnp.einsum('bthd,bhdv->bthv', qg, S)
        kd = ki * jnp.exp(b_last[:, None] - b)
        S = jnp.exp(b_last)[..., None] * S + jnp.einsum('bshd,bshv->bhdv', kd, vi)
        return S, o

    S, o = lax.scan(step, s0.astype(jnp.float32), (qc, kc, vc, gc))
    return jnp.moveaxis(o, 0, 1).reshape(B, T, H, -1), S


def _ab_project(h, w_in, w_gate, b_gate):
    B, T, _ = h.shape
    z = h @ w_in
    qa, ka, va, qb, kb, vb, g_lr, r = _split_cols(
        z, (A_WIDTH, A_WIDTH, A_WIDTH, B_KW, B_KW, B_VW, B_GATE_RANK, B_VW))
    log_a = jax.nn.log_sigmoid((g_lr @ w_gate + b_gate).astype(jnp.float32)) / B_GATE_TEMP
    rs = lambda t, H: t.reshape(B, T, H, -1)
    return (rs(qa, A_HEADS), rs(ka, A_HEADS), rs(va, A_HEADS),
            rs(qb, B_HEADS), rs(kb, B_HEADS), rs(vb, B_HEADS), rs(log_a, B_HEADS), r)


def _ab_merge(o_a, o_b, r, g_gla, w_out):
    B, T = o_a.shape[:2]
    ob = o_b.astype(jnp.float32)
    ob = ob * lax.rsqrt(jnp.mean(ob * ob, axis=-1, keepdims=True) + EPS)
    ob = ob.reshape(B, T, B_VW) * g_gla.astype(jnp.float32) * jax.nn.silu(r.astype(jnp.float32))
    cat = jnp.concatenate([o_a.reshape(B, T, A_WIDTH).astype(jnp.float32), ob], axis=-1)
    return cat @ w_out


def _band_attn(q, k, v, q_pos, k_pos, rel_table):
    s = jnp.einsum('bthd,bshd->bhts', q, k).astype(jnp.float32) * (HEAD_DIM ** -0.5)
    qc = q_pos // CHUNK
    kc = k_pos // CHUNK
    mask = ((kc[None, :] <= qc[:, None]) & (kc[None, :] >= qc[:, None] - C_LEFT_CHUNKS)
            & (k_pos[None, :] >= 0))
    rel = jnp.clip(q_pos[:, None] - k_pos[None, :], REL_MIN, REL_MAX) - REL_MIN
    s = s + rel_table[:, rel].astype(jnp.float32)[None]
    p = jax.nn.softmax(jnp.where(mask, s, -jnp.inf), axis=-1)
    return jnp.einsum('bhts,bshd->bthd', p.astype(v.dtype), v)


def _band_prompt(q, k, v, rel_table):
    B, S, H, d = q.shape
    n = S // CHUNK
    band = C_WINDOW + CHUNK
    pad = ((0, 0), (C_WINDOW, 0), (0, 0), (0, 0))
    kp, vp = jnp.pad(k, pad), jnp.pad(v, pad)
    qb = jnp.moveaxis(q.reshape(B, n, CHUNK, H, d), 1, 0)

    def one(args):
        qi, c = args
        start = c * CHUNK
        ki = lax.dynamic_slice_in_dim(kp, start, band, axis=1)
        vi = lax.dynamic_slice_in_dim(vp, start, band, axis=1)
        q_pos = start + jnp.arange(CHUNK, dtype=jnp.int32)
        k_pos = start - C_WINDOW + jnp.arange(band, dtype=jnp.int32)
        return _band_attn(qi, ki, vi, q_pos, k_pos, rel_table)

    out = lax.map(one, (qb, jnp.arange(n, dtype=jnp.int32)))
    return jnp.moveaxis(out, 0, 1).reshape(B, S, H, d)


def setup_inputs(seed: int = 0) -> dict:
    key = jax.random.key(seed)
    ks = jax.random.split(key, 21)

    def nrm(k, shape, scale):
        return jax.random.normal(k, shape, jnp.float32) * scale

    c_rows = min(C_WINDOW, PAST_LEN)
    return {
        "x_prompt": nrm(ks[0], (BATCH, SEQ, D_MODEL), 1.0),
        "x_sample": nrm(ks[1], (DEC_BATCH, DEC_SEQ, D_MODEL), 1.0),
        "cache_a_k": nrm(ks[2], (N_AB, DEC_BATCH, PAST_LEN, A_HEADS, HEAD_DIM), 1.0),
        "cache_a_v": nrm(ks[3], (N_AB, DEC_BATCH, PAST_LEN, A_HEADS, HEAD_DIM), 1.0),
        "state_b": nrm(ks[4], (N_AB, DEC_BATCH, B_HEADS, B_DK, B_DV), 0.1),
        "cache_c_k": nrm(ks[5], (N_C, DEC_BATCH, c_rows, C_HEADS, HEAD_DIM), 1.0),
        "cache_c_v": nrm(ks[6], (N_C, DEC_BATCH, c_rows, C_HEADS, HEAD_DIM), 1.0),
        "norm_mix_g": 1.0 + nrm(ks[7], (DEPTH, D_MODEL), 0.01),
        "norm_ffn_g": 1.0 + nrm(ks[8], (DEPTH, D_MODEL), 0.01),
        "w_in_ab": nrm(ks[9], (N_AB, D_MODEL, AB_IN), D_MODEL ** -0.5),
        "w_gate_b": nrm(ks[10], (N_AB, B_GATE_RANK, B_KW), B_GATE_RANK ** -0.5),
        "b_gate_b": nrm(ks[11], (N_AB, B_KW), 0.1),
        "norm_gla_g": 1.0 + nrm(ks[12], (N_AB, B_VW), 0.01),
        "w_out_ab": nrm(ks[13], (N_AB, AB_OUT, D_MODEL), AB_OUT ** -0.5),
        "w_qkv_c": nrm(ks[14], (N_C, D_MODEL, 3 * C_WIDTH), D_MODEL ** -0.5),
        "rel_bias_c": nrm(ks[15], (N_C, C_HEADS, N_REL), 0.1),
        "w_out_c": nrm(ks[16], (N_C, C_WIDTH, D_MODEL), C_WIDTH ** -0.5),
        "w_ffn_gate": nrm(ks[17], (DEPTH, D_MODEL, D_FF), D_MODEL ** -0.5),
        "w_ffn_up": nrm(ks[18], (DEPTH, D_MODEL, D_FF), D_MODEL ** -0.5),
        "w_ffn_down": nrm(ks[19], (DEPTH, D_FF, D_MODEL), D_FF ** -0.5),
        "norm_final_g": 1.0 + nrm(ks[20], (D_MODEL,), 0.01),
    }


def reference(x_prompt, x_sample, cache_a_k, cache_a_v, state_b, cache_c_k, cache_c_v,
              norm_mix_g, norm_ffn_g, w_in_ab, w_gate_b, b_gate_b, norm_gla_g, w_out_ab,
              w_qkv_c, rel_bias_c, w_out_c, w_ffn_gate, w_ffn_up, w_ffn_down, norm_final_g):
    xp, xs = x_prompt, x_sample
    Bp, Tp, _ = xp.shape
    Bs, Ts, _ = xs.shape
    P = PAST_LEN
    q_pos_s = P + jnp.arange(Ts, dtype=jnp.int32)
    a_kp, a_vp, a_ks, a_vs, b_sp, b_ss = [], [], [], [], [], []
    c_kp, c_vp, c_ks, c_vs = [], [], [], []

    for layer in range(DEPTH):
        i = layer // 2
        hp = _rmsnorm(xp, norm_mix_g[layer])
        hs = _rmsnorm(xs, norm_mix_g[layer])
        if layer % 2 == 0:
            qa, ka, va, qb, kb, vb, la, r = _ab_project(hp, w_in_ab[i], w_gate_b[i], b_gate_b[i])
            oa = _sb_prompt(qa, ka, va)
            s0 = jnp.zeros((Bp, B_HEADS, B_DK, B_DV), jnp.float32)
            ob, sbp = _gla(qb, kb, vb, la, s0, GLA_CHUNK)
            xp = xp + _ab_merge(oa, ob, r, norm_gla_g[i], w_out_ab[i]).astype(xp.dtype)

            qa2, ka2, va2, qb2, kb2, vb2, la2, r2 = _ab_project(hs, w_in_ab[i], w_gate_b[i], b_gate_b[i])
            k_all = jnp.concatenate([cache_a_k[i].astype(ka2.dtype), ka2], axis=1)
            v_all = jnp.concatenate([cache_a_v[i].astype(va2.dtype), va2], axis=1)
            oa2 = _sb_block(qa2, k_all, v_all, q_pos_s, jnp.arange(P + Ts, dtype=jnp.int32))
            ob2, sbs = _gla(qb2, kb2, vb2, la2, state_b[i], Ts)
            xs = xs + _ab_merge(oa2, ob2, r2, norm_gla_g[i], w_out_ab[i]).astype(xs.dtype)

            a_kp.append(ka); a_vp.append(va); a_ks.append(ka2); a_vs.append(va2)
            b_sp.append(sbp); b_ss.append(sbs)
        else:
            qc, kc, vc = [t.reshape(Bp, Tp, C_HEADS, HEAD_DIM)
                          for t in _split_cols(hp @ w_qkv_c[i], (C_WIDTH, C_WIDTH, C_WIDTH))]
            oc = _band_prompt(qc, kc, vc, rel_bias_c[i])
            xp = xp + (oc.reshape(Bp, Tp, C_WIDTH) @ w_out_c[i]).astype(xp.dtype)

            qc2, kc2, vc2 = [t.reshape(Bs, Ts, C_HEADS, HEAD_DIM)
                             for t in _split_cols(hs @ w_qkv_c[i], (C_WIDTH, C_WIDTH, C_WIDTH))]
            Wc = cache_c_k.shape[2]
            k_all = jnp.concatenate([cache_c_k[i].astype(kc2.dtype), kc2], axis=1)
            v_all = jnp.concatenate([cache_c_v[i].astype(vc2.dtype), vc2], axis=1)
            k_pos = P - Wc + jnp.arange(Wc + Ts, dtype=jnp.int32)
            oc2 = _band_attn(qc2, k_all, v_all, q_pos_s, k_pos, rel_bias_c[i])
            xs = xs + (oc2.reshape(Bs, Ts, C_WIDTH) @ w_out_c[i]).astype(xs.dtype)

            keep = min(C_WINDOW, Tp)
            c_kp.append(kc[:, Tp - keep:]); c_vp.append(vc[:, Tp - keep:])
            c_ks.append(kc2); c_vs.append(vc2)
        xp = xp + _swiglu(_rmsnorm(xp, norm_ffn_g[layer]), w_ffn_gate[layer], w_ffn_up[layer],
                          w_ffn_down[layer]).astype(xp.dtype)
        xs = xs + _swiglu(_rmsnorm(xs, norm_ffn_g[layer]), w_ffn_gate[layer], w_ffn_up[layer],
                          w_ffn_down[layer]).astype(xs.dtype)

    y_prompt = _rmsnorm(xp, norm_final_g)
    y_sample = _rmsnorm(xs, norm_final_g)
    a_k_prompt = jnp.stack(a_kp)
    a_v_prompt = jnp.stack(a_vp)
    a_k_sample = jnp.stack(a_ks)
    a_v_sample = jnp.stack(a_vs)
    b_state_prompt = jnp.stack(b_sp)
    b_state_sample = jnp.stack(b_ss)
    c_k_prompt = jnp.stack(c_kp)
    c_v_prompt = jnp.stack(c_vp)
    c_k_sample = jnp.stack(c_ks)
    c_v_sample = jnp.stack(c_vs)
    return (y_prompt, y_sample, a_k_prompt, a_v_prompt, a_k_sample, a_v_sample,
            b_state_prompt, b_state_sample, c_k_prompt, c_v_prompt, c_k_sample, c_v_sample)
```

```cpp
#include <hip/hip_runtime.h>
#include <hip/hip_cooperative_groups.h>
#include <cstdio>
#include <cstdint>
namespace cg = cooperative_groups;

#define LAS __attribute__((address_space(3)))
typedef unsigned short bf16_t;
typedef short bf16x8 __attribute__((ext_vector_type(8)));
typedef float f32x4 __attribute__((ext_vector_type(4)));
typedef float f32x16 __attribute__((ext_vector_type(16)));
typedef unsigned u32x4 __attribute__((ext_vector_type(4)));
typedef unsigned u32x2 __attribute__((ext_vector_type(2)));

constexpr int DM = 1024, TP = 2048, NB = 8, MPROMPT = NB * TP, TSAMP = 16, MSAMP = NB * TSAMP, MREAL = MPROMPT + MSAMP, MP = 16640;
constexpr int PAST = 2048, CWIN = 512;
constexpr int NZ_AB = 3328, NZ_C = 3072, DFF = 2816, NGU = 2 * DFF, AB_IN = 3088;
constexpr float EPS = 1e-6f;
constexpr bool SB_EARLY_EXIT = true;
constexpr float SB_EXIT_THR = -104.0f;

constexpr size_t O_YP = 0, O_YS = O_YP + (size_t)MPROMPT * DM, O_AKP = O_YS + (size_t)MSAMP * DM, O_AVP = O_AKP + (size_t)2 * MPROMPT * 512,
                 O_AKS = O_AVP + (size_t)2 * MPROMPT * 512, O_AVS = O_AKS + (size_t)2 * MSAMP * 512, O_BSP = O_AVS + (size_t)2 * MSAMP * 512,
                 O_BSS = O_BSP + (size_t)2 * NB * 4 * 64 * 128, O_CKP = O_BSS + (size_t)2 * NB * 4 * 64 * 128, O_CVP = O_CKP + (size_t)2 * NB * CWIN * 1024,
                 O_CKS = O_CVP + (size_t)2 * NB * CWIN * 1024, O_CVS = O_CKS + (size_t)2 * MSAMP * 1024, O_END = O_CVS + (size_t)2 * MSAMP * 1024;

constexpr size_t al256(size_t x) { return (x + 255) & ~(size_t)255; }
constexpr size_t WS_CTL = 0, WS_WIN = 1u << 20;
constexpr size_t SZ_WIN = (size_t)NZ_AB * DM * 2, SZ_WO = (size_t)DM * DM * 2, SZ_WQKV = (size_t)NZ_C * DM * 2, SZ_WGU = (size_t)NGU * DM * 2, SZ_WD = (size_t)DM * DFF * 2;
constexpr size_t WS_WOAB = WS_WIN + 2 * SZ_WIN, WS_WQKV = WS_WOAB + 2 * SZ_WO, WS_WOC = WS_WQKV + 2 * SZ_WQKV, WS_WGU = WS_WOC + 2 * SZ_WO, WS_WD = WS_WGU + 4 * SZ_WGU;
constexpr size_t WS_X = al256(WS_WD + 4 * SZ_WD), WS_H = WS_X + (size_t)MP * DM * 4, WS_Z = WS_H + (size_t)MP * DM * 2, WS_CAT = WS_Z + (size_t)MP * NZ_AB * 2,
                 WS_VT = WS_CAT + (size_t)MP * DM * 2, WS_GLA_OI = WS_VT + (size_t)1024 * MP * 2, WS_GLA_SPT = WS_GLA_OI + (size_t)1056 * 32768,
                 WS_GLA_QG = WS_GLA_SPT + (size_t)1056 * 16384, WS_GLA_D = WS_GLA_QG + (size_t)1056 * 8192, WS_GLA_UTS = WS_GLA_D + (size_t)1056 * 256, WS_PART = WS_GLA_UTS + (size_t)32 * 32768, WS_END = WS_PART + (size_t)11 * MSAMP * DM * 4;
static_assert((size_t)1024 * 32768 <= (size_t)MP * DM * 2, "prompt U^T images overlay H");

#ifndef REP_MIX_AB
#define REP_MIX_AB 0
#endif
#ifndef REP_MIX_C
#define REP_MIX_C 0
#endif
#ifndef REP_UP
#define REP_UP 0
#endif
constexpr int LDS_BYTES = 147456;

__device__ __forceinline__ unsigned cvt_pk_bf16(float lo, float hi) { unsigned r; asm volatile("v_cvt_pk_bf16_f32 %0, %1, %2" : "=v"(r) : "v"(lo), "v"(hi)); return r; }
__device__ __forceinline__ bf16_t f2bf(float f) { return (bf16_t)(cvt_pk_bf16(f, 0.f) & 0xffffu); }
__device__ __forceinline__ float bf2f(bf16_t v) { return __uint_as_float((unsigned)v << 16); }
__device__ __forceinline__ float bflo(unsigned v) { return __uint_as_float(v << 16); }
__device__ __forceinline__ float bfhi(unsigned v) { return __uint_as_float(v & 0xffff0000u); }
__device__ __forceinline__ float wave_sum(float v) {
#pragma unroll
    for (int o = 1; o < 64; o <<= 1) v += __shfl_xor(v, o);
    return v;
}
__device__ __forceinline__ float wave_max(float v) {
#pragma unroll
    for (int o = 1; o < 64; o <<= 1) v = fmaxf(v, __shfl_xor(v, o));
    return v;
}
__device__ __forceinline__ float log_sigmoid_f(float z) { return fminf(z, 0.f) - 0.69314718f * __builtin_amdgcn_logf(1.f + __expf(-fabsf(z))); }
__device__ __forceinline__ int crow(int r, int hi) { return (r & 3) + 8 * (r >> 2) + 4 * hi; }
#define LDS_WAIT() asm volatile("s_waitcnt lgkmcnt(0)" ::: "memory")
__device__ __forceinline__ int opaque_tid() { int t = threadIdx.x; asm volatile("" : "+v"(t)); return t; }

namespace pg8 {
constexpr int BM = 256, BK = 64, HALF = 128, HTB = HALF * BK * 2, STAGE_BYTES = 8 * HTB, NXCD = 8, WGM = 8;
__host__ __device__ __forceinline__ int lds_byte(int r, int c) { const int st = (r >> 4) * 2 + (c >> 5), rr = r & 15, cc = c & 31, ob = rr * 64 + cc * 2; return st * 1024 + (ob ^ (((ob >> 9) & 1) << 5)); }
__host__ __device__ __forceinline__ void stage_rc(int b, int& R, int& C) { const int st = b / 1024, sb = b % 1024, swz = sb ^ (((sb >> 9) & 1) << 5); R = (st >> 1) * 16 + swz / 64; C = (st & 1) * 32 + (swz % 64) / 2; }
__host__ __device__ __forceinline__ int perm32(int rho) { const int n = rho >> 4, i = rho & 15; return 8 * (i >> 2) + 4 * n + (i & 3); }
struct Unit { int pm, pn, kt0, nkt, split; };
struct Gemm { const bf16_t* A; const bf16_t* Bt; int M, N, K; };
struct StaticOrder {
    int nM, nN, nmain, nwg, G, c, ktiles, nsplit;
    __host__ __device__ void init(int Mmain, int N, int K, int nsplit_, int G_, int c_) { nM = Mmain / BM; nN = N / BM; nmain = nM * nN; ktiles = K / BK; nsplit = nsplit_; nwg = nmain + nN * nsplit; G = G_; c = c_; }
    __host__ __device__ bool next(int i, Unit& u) const {
        const long L = (long)i * G + c; if (L >= nwg) return false;
        if (L < nmain) {
            int wgid = (int)L; { const int q = nmain / NXCD, r = nmain % NXCD, xcd = wgid % NXCD, off = wgid / NXCD; wgid = (xcd < r ? xcd * (q + 1) : r * (q + 1) + (xcd - r) * q) + off; }
            const int nig = WGM * nN, gid = wgid / nig, fm = gid * WGM, gsz = (nM - fm) < WGM ? (nM - fm) : WGM;
            u.pm = fm + ((wgid % nig) % gsz); u.pn = (wgid % nig) / gsz; u.kt0 = 0; u.nkt = ktiles; u.split = 0;
        } else {
            const int s2 = (int)L - nmain; u.pm = nM; u.pn = s2 % nN; u.nkt = ktiles / nsplit; u.kt0 = (s2 / nN) * u.nkt; u.split = nsplit > 1 ? 1 : 0;
        }
        return true;
    }
};
template <class Epi>
__device__ __forceinline__ void gemm_phase(LAS unsigned char* lds, const Gemm g, const StaticOrder& S, const Epi& E) {
    const int tid = opaque_tid(), wid = __builtin_amdgcn_readfirstlane(tid >> 6), lane = tid & 63, wr = wid >> 2, wc = wid & 3, fr = lane & 15, fq = lane >> 4;
    const int K = g.K;
    unsigned voffA[2], voffB[2];
#pragma unroll
    for (int i = 0; i < 2; ++i) { int R, C; stage_rc(tid * 16 + i * 8192, R, C); const int Rb = Epi::PERM ? ((R & ~31) + perm32(R & 31)) : R;
        voffA[i] = (unsigned)(R * K + C) * 2u; voffB[i] = (unsigned)(Rb * K + C) * 2u; }
    const size_t kstep = (size_t)(BK * 2);
    const size_t hstep = (size_t)HALF * K * 2;
    const size_t tstep = 2 * hstep;
    const unsigned ldsw = (unsigned)wid * 1024u;
    const int aoff = lds_byte(wr * 64 + fr, fq * 8), boff = lds_byte(wc * 32 + fr, fq * 8);
#define PG8_SA(b, h) (((b) * 2 + (h)) * HTB)
#define PG8_SB(b, h) ((4 + (b) * 2 + (h)) * HTB)
#define PG8_STAGE(bufoff, gbase, voff) do { _Pragma("unroll") for (int _i = 0; _i < 2; ++_i) \
        __builtin_amdgcn_global_load_lds((const unsigned*)((const char*)(gbase) + (voff)[_i]), (LAS unsigned*)(lds + (bufoff) + ldsw + _i * 8192), 16, 0, 0); } while (0)
#define PG8_LDA(dst, b, h) do { _Pragma("unroll") for (int m = 0; m < 4; ++m) _Pragma("unroll") for (int k = 0; k < 2; ++k) dst[m][k] = *(const LAS bf16x8*)(lds + PG8_SA(b, h) + aoff + m * 2048 + k * 1024); } while (0)
#define PG8_LDB(dst, b, h) do { _Pragma("unroll") for (int n = 0; n < 2; ++n) _Pragma("unroll") for (int k = 0; k < 2; ++k) dst[n][k] = *(const LAS bf16x8*)(lds + PG8_SB(b, h) + boff + n * 2048 + k * 1024); } while (0)
#define PG8_MMA(ai, bj, At, Bt) do { __builtin_amdgcn_s_setprio(1); _Pragma("unroll") for (int m = 0; m < 4; ++m) _Pragma("unroll") for (int n = 0; n < 2; ++n) _Pragma("unroll") for (int k = 0; k < 2; ++k) \
        acc[ai][bj][m][n] = __builtin_amdgcn_mfma_f32_16x16x32_bf16(Bt[n][k], At[m][k], acc[ai][bj][m][n], 0, 0, 0); __builtin_amdgcn_s_setprio(0); } while (0)
#define PG8_WAIT_V(n) asm volatile("s_waitcnt vmcnt(" #n ")" ::: "memory")
#define PG8_WAIT_L(n) asm volatile("s_waitcnt lgkmcnt(" #n ")" ::: "memory")
#define PG8_BAR __builtin_amdgcn_s_barrier()
#define PG8_SCHED __builtin_amdgcn_sched_barrier(0)
    Unit cur, nxt; int ui = 0;
    if (!S.next(0, cur)) return;
    f32x4 acc[2][2][4][2];
    if constexpr (Epi::HAS_INIT) E.init(acc, cur, wr, wc, fr, fq);
    else {
#pragma unroll
    for (int a = 0; a < 2; ++a)
#pragma unroll
        for (int b = 0; b < 2; ++b)
#pragma unroll
            for (int m = 0; m < 4; ++m)
#pragma unroll
                for (int n = 0; n < 2; ++n) acc[a][b][m][n] = (f32x4){0.f, 0.f, 0.f, 0.f};
    }
    bf16x8 At[4][2], B0[2][2], B1[2][2];
    const char* cA = (const char*)g.A + (size_t)cur.pm * tstep + (size_t)cur.kt0 * kstep; const char* cB = (const char*)g.Bt + (size_t)cur.pn * tstep + (size_t)cur.kt0 * kstep;
    PG8_STAGE(PG8_SB(0, 0), cB, voffB); PG8_STAGE(PG8_SB(0, 1), cB + hstep, voffB); PG8_STAGE(PG8_SA(0, 0), cA, voffA); PG8_STAGE(PG8_SA(0, 1), cA + hstep, voffA);
    if (wr == 1) PG8_BAR;
    PG8_WAIT_V(2); PG8_BAR;
    PG8_STAGE(PG8_SB(1, 0), cB + kstep, voffB); PG8_STAGE(PG8_SA(1, 0), cA + kstep, voffA); PG8_STAGE(PG8_SB(1, 1), cB + hstep + kstep, voffB);
    PG8_WAIT_V(6); PG8_BAR;
    for (;;) {
        const bool has_next = S.next(ui + 1, nxt);
        const char* nA = has_next ? (const char*)g.A + (size_t)nxt.pm * tstep + (size_t)nxt.kt0 * kstep : cA; const char* nB = has_next ? (const char*)g.Bt + (size_t)nxt.pn * tstep + (size_t)nxt.kt0 * kstep : cB;
        const int nt = cur.nkt;
        for (int t = 0; t < nt; t += 2) {
            const bool last = (t == nt - 2);
            const char* a1 = cA + (size_t)(t + 1) * kstep;
            const char* a2 = last ? nA : cA + (size_t)(t + 2) * kstep; const char* b2 = last ? nB : cB + (size_t)(t + 2) * kstep;
            const char* a3 = a2 + kstep; const char* b3 = b2 + kstep;
            PG8_LDB(B0, 0, 0); PG8_LDB(B1, 0, 1); PG8_SCHED; PG8_LDA(At, 0, 0); PG8_STAGE(PG8_SA(1, 1), a1 + hstep, voffA);
            PG8_WAIT_V(8); PG8_WAIT_L(0); PG8_BAR; PG8_MMA(0, 0, At, B0); PG8_MMA(0, 1, At, B1); PG8_BAR; PG8_SCHED;
            PG8_LDA(At, 0, 1); PG8_STAGE(PG8_SB(0, 0), b2, voffB); PG8_STAGE(PG8_SB(0, 1), b2 + hstep, voffB); PG8_STAGE(PG8_SA(0, 0), a2, voffA);
            PG8_WAIT_V(8); PG8_WAIT_L(0); PG8_BAR; PG8_MMA(1, 0, At, B0); PG8_MMA(1, 1, At, B1); PG8_BAR; PG8_SCHED;
            PG8_LDB(B0, 1, 0); PG8_LDB(B1, 1, 1); PG8_SCHED; PG8_LDA(At, 1, 0); PG8_STAGE(PG8_SA(0, 1), a2 + hstep, voffA);
            PG8_WAIT_V(8); PG8_WAIT_L(0); PG8_BAR; PG8_MMA(0, 0, At, B0); PG8_MMA(0, 1, At, B1); PG8_BAR; PG8_SCHED;
            PG8_LDA(At, 1, 1); PG8_STAGE(PG8_SB(1, 0), b3, voffB); PG8_STAGE(PG8_SB(1, 1), b3 + hstep, voffB); PG8_STAGE(PG8_SA(1, 0), a3, voffA);
            PG8_WAIT_V(8); PG8_WAIT_L(0); PG8_BAR; PG8_MMA(1, 0, At, B0); PG8_MMA(1, 1, At, B1); PG8_BAR; PG8_SCHED;
        }
        if (wr == 0) PG8_BAR;
        E(acc, cur, wr, wc, fr, fq);
        if (!has_next) break;
        if constexpr (Epi::HAS_INIT) E.init(acc, nxt, wr, wc, fr, fq);
        else {
#pragma unroll
        for (int a = 0; a < 2; ++a)
#pragma unroll
            for (int b = 0; b < 2; ++b)
#pragma unroll
                for (int m = 0; m < 4; ++m)
#pragma unroll
                    for (int n = 0; n < 2; ++n) acc[a][b][m][n] = (f32x4){0.f, 0.f, 0.f, 0.f};
        }
        cur = nxt; cA = nA; cB = nB; ++ui;
        if (wr == 1) PG8_BAR;
    }
    PG8_WAIT_V(0);
    PG8_BAR;
#undef PG8_SA
#undef PG8_SB
#undef PG8_STAGE
#undef PG8_LDA
#undef PG8_LDB
#undef PG8_MMA
#undef PG8_WAIT_V
#undef PG8_WAIT_L
#undef PG8_BAR
#undef PG8_SCHED
}
}

struct EpiInAB {
    static constexpr bool PERM = true, HAS_INIT = false;
    bf16_t* Z; bf16_t* VT; float* akp; float* avp; float* aks; float* avs;
    __device__ __forceinline__ void operator()(const f32x4 (&acc)[2][2][4][2], const pg8::Unit& u, int wr, int wc, int fr, int fq) const {
        const int pn = u.pn, colb = pn * 256 + wc * 32 + 8 * fq;
        const bool isk = (pn == 2 || pn == 3), isv = (pn == 4 || pn == 5), isvb = (pn == 8 || pn == 9);
#pragma unroll
        for (int ai = 0; ai < 2; ++ai)
#pragma unroll
            for (int m = 0; m < 4; ++m) {
                const int row = u.pm * 256 + ai * 128 + wr * 64 + m * 16 + fr;
#pragma unroll
                for (int bj = 0; bj < 2; ++bj) {
                    const int c = colb + bj * 128; const f32x4 v0 = acc[ai][bj][m][0], v1 = acc[ai][bj][m][1];
                    u32x4 w; w.x = cvt_pk_bf16(v0[0], v0[1]); w.y = cvt_pk_bf16(v0[2], v0[3]); w.z = cvt_pk_bf16(v1[0], v1[1]); w.w = cvt_pk_bf16(v1[2], v1[3]);
                    *(u32x4*)(Z + (size_t)row * NZ_AB + c) = w;
                    if (isk || isv) {
                        const int cc = c - (isk ? 512 : 1024);
                        float* dst = nullptr;
                        if (row < MPROMPT) dst = (isk ? akp : avp) + (size_t)row * 512 + cc;
                        else if (row < MREAL) dst = (isk ? aks : avs) + (size_t)(row - MPROMPT) * 512 + cc;
                        if (dst) { __builtin_nontemporal_store(v0, (f32x4*)dst); __builtin_nontemporal_store(v1, (f32x4*)(dst + 4)); }
                    }
                    if (isv || isvb) {
                        const int vc = isv ? (c - 1024) : (512 + c - 2048);
                        bf16_t* p = VT + (size_t)vc * MP + row;
                        p[0] = (bf16_t)(w.x & 0xffffu); p[(size_t)MP] = (bf16_t)(w.x >> 16); p[(size_t)2 * MP] = (bf16_t)(w.y & 0xffffu); p[(size_t)3 * MP] = (bf16_t)(w.y >> 16);
                        p[(size_t)4 * MP] = (bf16_t)(w.z & 0xffffu); p[(size_t)5 * MP] = (bf16_t)(w.z >> 16); p[(size_t)6 * MP] = (bf16_t)(w.w & 0xffffu); p[(size_t)7 * MP] = (bf16_t)(w.w >> 16);
                    }
                }
            }
    }
};
struct EpiInC {
    static constexpr bool PERM = true, HAS_INIT = false;
    bf16_t* Z; bf16_t* VT; float* ckp; float* cvp; float* cks; float* cvs;
    __device__ __forceinline__ void operator()(const f32x4 (&acc)[2][2][4][2], const pg8::Unit& u, int wr, int wc, int fr, int fq) const {
        const int pn = u.pn, colb = pn * 256 + wc * 32 + 8 * fq;
        const bool isk = (pn >= 4 && pn < 8), isv = (pn >= 8);
#pragma unroll
        for (int ai = 0; ai < 2; ++ai)
#pragma unroll
            for (int m = 0; m < 4; ++m) {
                const int row = u.pm * 256 + ai * 128 + wr * 64 + m * 16 + fr;
#pragma unroll
                for (int bj = 0; bj < 2; ++bj) {
                    const int c = colb + bj * 128; const f32x4 v0 = acc[ai][bj][m][0], v1 = acc[ai][bj][m][1];
                    u32x4 w; w.x = cvt_pk_bf16(v0[0], v0[1]); w.y = cvt_pk_bf16(v0[2], v0[3]); w.z = cvt_pk_bf16(v1[0], v1[1]); w.w = cvt_pk_bf16(v1[2], v1[3]);
                    *(u32x4*)(Z + (size_t)row * NZ_C + c) = w;
                    if (isk || isv) {
                        const int cc = c - (isk ? 1024 : 2048);
                        float* dst = nullptr;
                        if (row < MPROMPT) { const int t = row & (TP - 1), b = row >> 11; if (t >= TP - CWIN) dst = (isk ? ckp : cvp) + ((size_t)b * CWIN + (t - (TP - CWIN))) * 1024 + cc; }
                        else if (row < MREAL) dst = (isk ? cks : cvs) + (size_t)(row - MPROMPT) * 1024 + cc;
                        if (dst) { __builtin_nontemporal_store(v0, (f32x4*)dst); __builtin_nontemporal_store(v1, (f32x4*)(dst + 4)); }
                    }
                    if (isv) {
                        const int vc = c - 2048;
                        bf16_t* p = VT + (size_t)vc * MP + row;
                        p[0] = (bf16_t)(w.x & 0xffffu); p[(size_t)MP] = (bf16_t)(w.x >> 16); p[(size_t)2 * MP] = (bf16_t)(w.y & 0xffffu); p[(size_t)3 * MP] = (bf16_t)(w.y >> 16);
                        p[(size_t)4 * MP] = (bf16_t)(w.z & 0xffffu); p[(size_t)5 * MP] = (bf16_t)(w.z >> 16); p[(size_t)6 * MP] = (bf16_t)(w.w & 0xffffu); p[(size_t)7 * MP] = (bf16_t)(w.w >> 16);
                    }
                }
            }
    }
};
struct EpiResid {
    static constexpr bool PERM = false, HAS_INIT = true;
    float* X; float* P;
    __device__ __forceinline__ void init(f32x4 (&acc)[2][2][4][2], const pg8::Unit& u, int wr, int wc, int fr, int fq) const {
        const int col0 = u.pn * 256 + wc * 32 + 4 * fq;
        if (u.split) {
#pragma unroll
            for (int ai = 0; ai < 2; ++ai)
#pragma unroll
                for (int bj = 0; bj < 2; ++bj)
#pragma unroll
                    for (int m = 0; m < 4; ++m)
#pragma unroll
                        for (int n = 0; n < 2; ++n) acc[ai][bj][m][n] = (f32x4){0.f, 0.f, 0.f, 0.f};
            return;
        }
#pragma unroll
        for (int ai = 0; ai < 2; ++ai)
#pragma unroll
            for (int m = 0; m < 4; ++m) {
                const float* rp = X + (size_t)(u.pm * 256 + ai * 128 + wr * 64 + m * 16 + fr) * DM + col0;
#pragma unroll
                for (int bj = 0; bj < 2; ++bj)
#pragma unroll
                    for (int n = 0; n < 2; ++n) acc[ai][bj][m][n] = __builtin_nontemporal_load((const f32x4*)(rp + bj * 128 + n * 16));
            }
    }
    __device__ __forceinline__ void operator()(const f32x4 (&acc)[2][2][4][2], const pg8::Unit& u, int wr, int wc, int fr, int fq) const {
        const int col0 = u.pn * 256 + wc * 32 + 4 * fq;
        if (u.split) {
            float* pb = P + (size_t)(u.kt0 / u.nkt) * MSAMP * DM;
#pragma unroll
            for (int m = 0; m < 4; ++m) {
                float* rp = pb + (size_t)(wr * 64 + m * 16 + fr) * DM + col0;
#pragma unroll
                for (int bj = 0; bj < 2; ++bj)
#pragma unroll
                    for (int n = 0; n < 2; ++n) *(f32x4*)(rp + bj * 128 + n * 16) = acc[0][bj][m][n];
            }
            return;
        }
#pragma unroll
        for (int ai = 0; ai < 2; ++ai)
#pragma unroll
            for (int m = 0; m < 4; ++m) {
                float* rp = X + (size_t)(u.pm * 256 + ai * 128 + wr * 64 + m * 16 + fr) * DM + col0;
#pragma unroll
                for (int bj = 0; bj < 2; ++bj)
#pragma unroll
                    for (int n = 0; n < 2; ++n) *(f32x4*)(rp + bj * 128 + n * 16) = acc[ai][bj][m][n];
            }
    }
};
struct EpiSwiglu {
    static constexpr bool PERM = true, HAS_INIT = false;
    bf16_t* G;
    __device__ __forceinline__ void operator()(const f32x4 (&acc)[2][2][4][2], const pg8::Unit& u, int wr, int wc, int fr, int fq) const {
        const int col0 = u.pn * 128 + wc * 32 + 8 * fq;
#pragma unroll
        for (int ai = 0; ai < 2; ++ai)
#pragma unroll
            for (int m = 0; m < 4; ++m) {
                const int row = u.pm * 256 + ai * 128 + wr * 64 + m * 16 + fr;
                float o[8];
#pragma unroll
                for (int n = 0; n < 2; ++n)
#pragma unroll
                    for (int j = 0; j < 4; ++j) { const float g = acc[ai][0][m][n][j], uu = acc[ai][1][m][n][j]; o[n * 4 + j] = g * __builtin_amdgcn_rcpf(1.f + __expf(-g)) * uu; }
                u32x4 w; w.x = cvt_pk_bf16(o[0], o[1]); w.y = cvt_pk_bf16(o[2], o[3]); w.z = cvt_pk_bf16(o[4], o[5]); w.w = cvt_pk_bf16(o[6], o[7]);
                *(u32x4*)(G + (size_t)row * DFF + col0) = w;
            }
    }
};

__device__ __forceinline__ void tr_item(const float* W, int K, int Nsrc, int c0, int nvalid, bf16_t* WT, int r0, int k0, LAS float* scr, int lane) {
    const int cc = lane & 31;
    float tv[32];
#pragma unroll
    for (int i = 0; i < 32; ++i) { const int kk = 2 * i + (lane >> 5); tv[i] = (cc < nvalid) ? __builtin_nontemporal_load(W + (size_t)(k0 + kk) * Nsrc + c0 + cc) : 0.f; }
#pragma unroll
    for (int i = 0; i < 32; ++i) { const int kk = 2 * i + (lane >> 5); scr[kk * 33 + cc] = tv[i]; }
    LDS_WAIT();
    const int c = lane & 7;
#pragma unroll
    for (int j = 0; j < 4; ++j) { const int n = (lane >> 3) + 8 * j; const LAS float* s = scr + (8 * c) * 33 + n;
        u32x4 o; o.x = cvt_pk_bf16(s[0 * 33], s[1 * 33]); o.y = cvt_pk_bf16(s[2 * 33], s[3 * 33]); o.z = cvt_pk_bf16(s[4 * 33], s[5 * 33]); o.w = cvt_pk_bf16(s[6 * 33], s[7 * 33]);
        *(u32x4*)(WT + (size_t)(r0 + n) * K + k0 + 8 * c) = o; }
    LDS_WAIT();
}

struct Args { const float* in[21]; float* out; unsigned char* ws; };
enum { I_XP = 0, I_XS, I_CAK, I_CAV, I_SB, I_CCK, I_CCV, I_GMIX, I_GFFN, I_WIN, I_WGATE, I_BGATE, I_GGLA, I_WOAB, I_WQKV, I_REL, I_WOC, I_WFG, I_WFU, I_WFD, I_GFIN };

#define CAS4 __attribute__((address_space(4)))
__device__ __forceinline__ const CAS4 Args& fresh_args() { const CAS4 Args* p = (const CAS4 Args*)__builtin_amdgcn_kernarg_segment_ptr(); asm volatile("" : "+s"(p)); return *p; }

__device__ __forceinline__ void prologue_weights(const CAS4 Args& a, LAS unsigned char* lds, int gw, int NGW, int wave, int lane) {
    lane = opaque_tid() & 63;
    LAS float* scr = (LAS float*)(lds + wave * 16384);
    unsigned char* ws = a.ws;
    constexpr int KB1 = DM / 64, KB2 = DFF / 64;
    constexpr int N_IN = 2 * (NZ_AB / 32) * KB1, N_OAB = 2 * 32 * KB1, N_QKV = 2 * (NZ_C / 32) * KB1, N_OC = 2 * 32 * KB1, N_GU = 4 * (NGU / 32) * KB1, N_D = 4 * 32 * KB2;
    constexpr int NITEMS = N_IN + N_OAB + N_QKV + N_OC + N_GU + N_D;
    for (int it = gw; it < NITEMS; it += NGW) {
        int r = it;
        if (r < N_IN) { const int per = (NZ_AB / 32) * KB1, L = r / per, q = r % per, db = q / KB1, kb = q % KB1;
            int c0, nv; if (db < 80) { c0 = 32 * db; nv = 32; } else if (db < 96) { c0 = 2576 + 32 * (db - 80); nv = 32; } else if (db == 96) { c0 = 2560; nv = 16; } else { c0 = 0; nv = 0; }
            tr_item(a.in[I_WIN] + (size_t)L * DM * AB_IN, DM, AB_IN, c0, nv, (bf16_t*)(ws + WS_WIN + L * SZ_WIN), 32 * db, 64 * kb, scr, lane); continue; } r -= N_IN;
        if (r < N_OAB) { const int per = 32 * KB1, L = r / per, q = r % per, db = q / KB1, kb = q % KB1;
            tr_item(a.in[I_WOAB] + (size_t)L * DM * DM, DM, DM, 32 * db, 32, (bf16_t*)(ws + WS_WOAB + L * SZ_WO), 32 * db, 64 * kb, scr, lane); continue; } r -= N_OAB;
        if (r < N_QKV) { const int per = (NZ_C / 32) * KB1, L = r / per, q = r % per, db = q / KB1, kb = q % KB1;
            tr_item(a.in[I_WQKV] + (size_t)L * DM * NZ_C, DM, NZ_C, 32 * db, 32, (bf16_t*)(ws + WS_WQKV + L * SZ_WQKV), 32 * db, 64 * kb, scr, lane); continue; } r -= N_QKV;
        if (r < N_OC) { const int per = 32 * KB1, L = r / per, q = r % per, db = q / KB1, kb = q % KB1;
            tr_item(a.in[I_WOC] + (size_t)L * DM * DM, DM, DM, 32 * db, 32, (bf16_t*)(ws + WS_WOC + L * SZ_WO), 32 * db, 64 * kb, scr, lane); continue; } r -= N_OC;
        if (r < N_GU) { const int per = (NGU / 32) * KB1, L = r / per, q = r % per, db = q / KB1, kb = q % KB1, tile = db >> 3, wi = db & 7;
            const float* src = (wi < 4 ? a.in[I_WFG] : a.in[I_WFU]) + (size_t)L * DM * DFF;
            tr_item(src, DM, DFF, 128 * tile + 32 * (wi & 3), 32, (bf16_t*)(ws + WS_WGU + L * SZ_WGU), 32 * db, 64 * kb, scr, lane); continue; } r -= N_GU;
        { const int per = 32 * KB2, L = r / per, q = r % per, db = q / KB2, kb = q % KB2;
            tr_item(a.in[I_WFD] + (size_t)L * DFF * DM, DFF, DM, 32 * db, 32, (bf16_t*)(ws + WS_WD + L * SZ_WD), 32 * db, 64 * kb, scr, lane); }
    }
}

__device__ __forceinline__ void norm_phase(const float* xp, const float* xs, float* X, const float* g, bf16_t* H, const float* P, int nsplit, bool first, int gw, int NGW, int lane) {
    lane = opaque_tid() & 63;
    f32x4 gv[4];
#pragma unroll
    for (int j = 0; j < 4; ++j) gv[j] = *((const f32x4*)g + lane + 64 * j);
    for (int row = gw; row < MP; row += NGW) {
        const float* src = X + (size_t)row * DM;
        if (first) src = row < MPROMPT ? xp + (size_t)row * DM : (row < MREAL ? xs + (size_t)(row - MPROMPT) * DM : nullptr);
        f32x4 v[4];
#pragma unroll
        for (int j = 0; j < 4; ++j) v[j] = src ? __builtin_nontemporal_load((const f32x4*)src + lane + 64 * j) : (f32x4){0.f, 0.f, 0.f, 0.f};
        const bool fold = !first && row >= MPROMPT && row < MREAL;
        if (fold) {
            for (int s2 = 0; s2 < nsplit; s2 += 4) { f32x4 t[4][4];
#pragma unroll
                for (int k = 0; k < 4; ++k) { const int sk = (s2 + k < nsplit) ? s2 + k : s2; const f32x4* pp = (const f32x4*)(P + ((size_t)sk * MSAMP + (row - MPROMPT)) * DM) + lane;
#pragma unroll
                    for (int j = 0; j < 4; ++j) t[k][j] = pp[64 * j]; }
#pragma unroll
                for (int k = 0; k < 4; ++k) if (s2 + k < nsplit) {
#pragma unroll
                    for (int j = 0; j < 4; ++j) v[j] = v[j] + t[k][j]; } }
        }
        float s = 0.f;
#pragma unroll
        for (int j = 0; j < 4; ++j) s += (v[j].x * v[j].x + v[j].y * v[j].y) + (v[j].z * v[j].z + v[j].w * v[j].w);
        const float rs = rsqrtf(wave_sum(s) * (1.f / DM) + EPS);
        u32x2* o = (u32x2*)(H + (size_t)row * DM) + lane;
#pragma unroll
        for (int j = 0; j < 4; ++j) { const f32x4 y = v[j] * rs * gv[j]; u32x2 w; w.x = cvt_pk_bf16(y.x, y.y); w.y = cvt_pk_bf16(y.z, y.w); o[64 * j] = w;
            if (first || fold) *((f32x4*)(X + (size_t)row * DM) + lane + 64 * j) = v[j]; }
    }
}
__device__ __forceinline__ void final_norm_phase(const float* X, const float* g, float* Y, const float* P, int nsplit, int gw, int NGW, int lane) {
    lane = opaque_tid() & 63;
    f32x4 gv[4];
#pragma unroll
    for (int j = 0; j < 4; ++j) gv[j] = *((const f32x4*)g + lane + 64 * j);
    for (int row = gw; row < MREAL; row += NGW) {
        const float* src = X + (size_t)row * DM;
        f32x4 v[4];
#pragma unroll
        for (int j = 0; j < 4; ++j) v[j] = __builtin_nontemporal_load((const f32x4*)src + lane + 64 * j);
        if (row >= MPROMPT) {
            for (int s2 = 0; s2 < nsplit; s2 += 4) { f32x4 t[4][4];
#pragma unroll
                for (int k = 0; k < 4; ++k) { const int sk = (s2 + k < nsplit) ? s2 + k : s2; const f32x4* pp = (const f32x4*)(P + ((size_t)sk * MSAMP + (row - MPROMPT)) * DM) + lane;
#pragma unroll
                    for (int j = 0; j < 4; ++j) t[k][j] = pp[64 * j]; }
#pragma unroll
                for (int k = 0; k < 4; ++k) if (s2 + k < nsplit) {
#pragma unroll
                    for (int j = 0; j < 4; ++j) v[j] = v[j] + t[k][j]; } }
        }
        float s = 0.f;
#pragma unroll
        for (int j = 0; j < 4; ++j) s += (v[j].x * v[j].x + v[j].y * v[j].y) + (v[j].z * v[j].z + v[j].w * v[j].w);
        const float rs = rsqrtf(wave_sum(s) * (1.f / DM) + EPS);
#pragma unroll
        for (int j = 0; j < 4; ++j) __builtin_nontemporal_store(v[j] * rs * gv[j], (f32x4*)(Y + (size_t)row * DM) + lane + 64 * j);
    }
}

#define MFMA32(a, b, c) __builtin_amdgcn_mfma_f32_32x32x16_bf16(a, b, c, 0, 0, 0)
#define MFMA16(a, b, c) __builtin_amdgcn_mfma_f32_16x16x32_bf16(a, b, c, 0, 0, 0)

__device__ __forceinline__ bf16x8 ld_vt(const bf16_t* p) {
    const u32x2 lo = *(const u32x2*)p, hi = *(const u32x2*)(p + 8);
    u32x4 t; t.x = lo.x; t.y = lo.y; t.z = hi.x; t.w = hi.y; return __builtin_bit_cast(bf16x8, t);
}
__device__ __forceinline__ bf16x8 pack8(const float* w) {
    u32x4 t; t.x = cvt_pk_bf16(w[0], w[1]); t.y = cvt_pk_bf16(w[2], w[3]); t.z = cvt_pk_bf16(w[4], w[5]); t.w = cvt_pk_bf16(w[6], w[7]); return __builtin_bit_cast(bf16x8, t);
}
__device__ __forceinline__ void store_ot(const f32x16& o0, const f32x16& o1, float sc, bf16_t* dst  , int hi) {
#pragma unroll
    for (int mt = 0; mt < 2; ++mt)
#pragma unroll
        for (int g = 0; g < 4; ++g) { const f32x16& o = mt ? o1 : o0; u32x2 w; w.x = cvt_pk_bf16(o[4 * g] * sc, o[4 * g + 1] * sc); w.y = cvt_pk_bf16(o[4 * g + 2] * sc, o[4 * g + 3] * sc);
            *(u32x2*)(dst + 32 * mt + 8 * g + 4 * hi) = w; }
}

__device__ __forceinline__ void sb_prompt_unit(const bf16_t* Z, const bf16_t* VT, bf16_t* CAT, LAS unsigned char* lds, int b, int h, int qb, int wave) {
    const int tid = opaque_tid(), lane = tid & 63;
    const int n = lane & 31, hi = lane >> 5;
    const int q0 = qb * 256 + wave * 32, qpos = q0 + n, ktd = q0 >> 5;
    const size_t rowb = (size_t)b * TP;
    bf16x8 bq[4];
#pragma unroll
    for (int s = 0; s < 4; ++s) bq[s] = *(const bf16x8*)(Z + (rowb + qpos) * NZ_AB + h * 64 + 16 * s + 8 * hi);
    f32x16 o0, o1;
#pragma unroll
    for (int r = 0; r < 16; ++r) { o0[r] = 0.f; o1[r] = 0.f; }
    float carry = 0.f; bool done = false;
    const int srow = tid >> 3, sseg = tid & 7, soff = srow * 144 + sseg * 16;
    const bf16_t* kgp = Z + (rowb + srow) * NZ_AB + 512 + h * 64 + sseg * 8;
    const bf16_t* vgp = VT + (size_t)(h * 64 + srow) * MP + rowb + sseg * 8;
    LAS int* dflag = (LAS int*)(lds + 36864);
    const int kc_first = 4 * qb + 3;
    u32x4 rk = *(const u32x4*)(kgp + (size_t)(kc_first * 64) * NZ_AB), rv = *(const u32x4*)(vgp + kc_first * 64);
    *(LAS u32x4*)(lds + soff) = rk; *(LAS u32x4*)(lds + 9216 + soff) = rv;
    __syncthreads();
    int buf = 0;
    for (int kc = kc_first; kc >= 0; --kc) {
        if (kc > 0) { rk = *(const u32x4*)(kgp + (size_t)((kc - 1) * 64) * NZ_AB); rv = *(const u32x4*)(vgp + (kc - 1) * 64); }
        const LAS unsigned char* kb = lds + buf * 18432; const LAS unsigned char* vb = kb + 9216;
#pragma unroll
        for (int half = 1; half >= 0; --half) {
            const int kt = 2 * kc + half;
            if (kt <= ktd && !done) {
                bf16x8 ak[4], av[2][2];
#pragma unroll
                for (int s = 0; s < 4; ++s) ak[s] = *(const LAS bf16x8*)(kb + (32 * half + n) * 144 + 32 * s + 16 * hi);
#pragma unroll
                for (int s2 = 0; s2 < 2; ++s2)
#pragma unroll
                    for (int mt = 0; mt < 2; ++mt) { const LAS unsigned char* p = vb + (32 * mt + n) * 144 + (32 * half + 16 * s2 + 4 * hi) * 2;
                        const u32x2 lo = *(const LAS u32x2*)p, hi2 = *(const LAS u32x2*)(p + 16); u32x4 t; t.x = lo.x; t.y = lo.y; t.z = hi2.x; t.w = hi2.y; av[s2][mt] = __builtin_bit_cast(bf16x8, t); }
                f32x16 st;
#pragma unroll
                for (int r = 0; r < 16; ++r) st[r] = 0.f;
#pragma unroll
                for (int s = 0; s < 4; ++s) st = MFMA32(ak[s], bq[s], st);
                const bool diag = (kt == ktd);
                float lb[16], lk[16];
#pragma unroll
                for (int r = 0; r < 16; ++r) { const float z2 = st[r] * 0.18033688f; const float l2 = fminf(z2, 0.f) - __builtin_amdgcn_logf(1.f + __builtin_amdgcn_exp2f(-fabsf(z2))); lb[r] = l2; lk[r] = l2 - z2; }
                if (diag) {
#pragma unroll
                    for (int r = 0; r < 16; ++r) { const int key = kt * 32 + crow(r, hi); if (key >= qpos) { lk[r] = 0.f; lb[r] = -1e30f; } }
                }
                float gs[4], pg[4];
#pragma unroll
                for (int g = 0; g < 4; ++g) { gs[g] = (lk[4 * g] + lk[4 * g + 1]) + (lk[4 * g + 2] + lk[4 * g + 3]); pg[g] = __shfl_xor(gs[g], 32); }
                float T[5]; T[4] = 0.f;
#pragma unroll
                for (int g = 3; g >= 0; --g) T[g] = T[g + 1] + (gs[g] + pg[g]);
                float w[16];
#pragma unroll
                for (int g = 0; g < 4; ++g) {
                    const float gsuf = carry + T[g + 1] + (hi == 0 ? pg[g] : 0.f);
                    const float e2 = lk[4 * g + 3], e1 = e2 + lk[4 * g + 2], e0 = e1 + lk[4 * g + 1];
                    const float af[4] = {gsuf + e0, gsuf + e1, gsuf + e2, gsuf};
#pragma unroll
                    for (int j = 0; j < 4; ++j) { const int r = 4 * g + j; w[r] = __builtin_amdgcn_exp2f(lb[r] + af[j]); }
                }
                carry += T[0];
#pragma unroll
                for (int s2 = 0; s2 < 2; ++s2) { const bf16x8 bw = pack8(w + 8 * s2); o0 = MFMA32(av[s2][0], bw, o0); o1 = MFMA32(av[s2][1], bw, o1); }
                if (SB_EARLY_EXIT && __all(carry < SB_EXIT_THR * 1.44269504f)) done = true;
            }
        }
        if (kc > 0) { const int nb = (buf ^ 1) * 18432; *(LAS u32x4*)(lds + nb + soff) = rk; *(LAS u32x4*)(lds + nb + 9216 + soff) = rv; }
        LAS int* df = dflag + (kc & 1) * 8;
        if (lane == 0) df[wave] = done ? 1 : 0;
        __syncthreads();
        const int alld = (df[0] & df[1]) & (df[2] & df[3]) & (df[4] & df[5]) & (df[6] & df[7]);
        if (alld) break;
        buf ^= 1;
    }
    store_ot(o0, o1, 1.f, CAT + (rowb + qpos) * DM + h * 64, hi);
}

__device__ __forceinline__ void band_prompt_unit(const bf16_t* Z, const bf16_t* VT, bf16_t* CAT, const LAS float* sbias, LAS unsigned char* lds, int b, int h, int qb, int wave) {
    const int tid = opaque_tid(), lane = tid & 63;
    const int n = lane & 31, hi = lane >> 5;
    const int c0 = qb * 4, cw = c0 + (wave >> 1);
    const int q0 = qb * 256 + wave * 32, qpos = q0 + n;
    const size_t rowb = (size_t)b * TP;
    bf16x8 bq[4];
#pragma unroll
    for (int s = 0; s < 4; ++s) bq[s] = *(const bf16x8*)(Z + (rowb + qpos) * NZ_C + h * 64 + 16 * s + 8 * hi);
    f32x16 o0, o1;
#pragma unroll
    for (int r = 0; r < 16; ++r) { o0[r] = 0.f; o1[r] = 0.f; }
    float mrun = -1e30f, lrun = 0.f;
    const int srow = tid >> 3, sseg = tid & 7, soff = srow * 144 + sseg * 16;
    const bf16_t* kgp = Z + (rowb + srow) * NZ_C + 1024 + h * 64 + sseg * 8;
    const bf16_t* vgp = VT + (size_t)(h * 64 + srow) * MP + rowb + sseg * 8;
    const int kc_first = (c0 >= 8) ? (c0 - 8) : 0, kc_last = c0 + 3;
    u32x4 rk = *(const u32x4*)(kgp + (size_t)(kc_first * 64) * NZ_C), rv = *(const u32x4*)(vgp + kc_first * 64);
    *(LAS u32x4*)(lds + soff) = rk; *(LAS u32x4*)(lds + 9216 + soff) = rv;
    __syncthreads();
    int buf = 0;
    for (int kc = kc_first; kc <= kc_last; ++kc) {
        if (kc < kc_last) { rk = *(const u32x4*)(kgp + (size_t)((kc + 1) * 64) * NZ_C); rv = *(const u32x4*)(vgp + (kc + 1) * 64); }
        if (kc >= cw - 8 && kc <= cw) {
            const LAS unsigned char* kb = lds + buf * 18432; const LAS unsigned char* vb = kb + 9216;
#pragma unroll
            for (int half = 0; half < 2; ++half) {
                const int kt = 2 * kc + half;
                bf16x8 ak[4], av[2][2];
#pragma unroll
                for (int s = 0; s < 4; ++s) ak[s] = *(const LAS bf16x8*)(kb + (32 * half + n) * 144 + 32 * s + 16 * hi);
#pragma unroll
                for (int s2 = 0; s2 < 2; ++s2)
#pragma unroll
                    for (int mt = 0; mt < 2; ++mt) { const LAS unsigned char* p = vb + (32 * mt + n) * 144 + (32 * half + 16 * s2 + 4 * hi) * 2;
                        const u32x2 lo = *(const LAS u32x2*)p, hi2 = *(const LAS u32x2*)(p + 16); u32x4 t; t.x = lo.x; t.y = lo.y; t.z = hi2.x; t.w = hi2.y; av[s2][mt] = __builtin_bit_cast(bf16x8, t); }
                f32x16 st;
#pragma unroll
                for (int r = 0; r < 16; ++r) st[r] = 0.f;
#pragma unroll
                for (int s = 0; s < 4; ++s) st = MFMA32(ak[s], bq[s], st);
                const LAS float* bp = sbias + (qpos + 63 - 27 - 4 * hi - 32 * kt);
                float sv[16]; float mx = -1e30f;
#pragma unroll
                for (int r = 0; r < 16; ++r) { sv[r] = st[r] * 0.18033688f + bp[27 - ((r & 3) + 8 * (r >> 2))]; mx = fmaxf(mx, sv[r]); }
                mx = fmaxf(mx, __shfl_xor(mx, 32));
                const float mnew = fmaxf(mrun, mx), alpha = __builtin_amdgcn_exp2f(mrun - mnew);
                float w[16]; float ps = 0.f;
#pragma unroll
                for (int r = 0; r < 16; ++r) { w[r] = __builtin_amdgcn_exp2f(sv[r] - mnew); ps += w[r]; }
                lrun = lrun * alpha + ps; mrun = mnew;
                if (!__all(alpha == 1.0f)) {
#pragma unroll
                    for (int r = 0; r < 16; ++r) { o0[r] *= alpha; o1[r] *= alpha; }
                }
#pragma unroll
                for (int s2 = 0; s2 < 2; ++s2) { const bf16x8 bw = pack8(w + 8 * s2); o0 = MFMA32(av[s2][0], bw, o0); o1 = MFMA32(av[s2][1], bw, o1); }
            }
        }
        if (kc < kc_last) { const int nb = (buf ^ 1) * 18432; *(LAS u32x4*)(lds + nb + soff) = rk; *(LAS u32x4*)(lds + nb + 9216 + soff) = rv; }
        __syncthreads();
        buf ^= 1;
    }
    const float l = lrun + __shfl_xor(lrun, 32);
    store_ot(o0, o1, 1.f / l, CAT + (rowb + qpos) * DM + h * 64, hi);
}

template <int MODE, int NQ>
__device__ __forceinline__ void sample_attn_item(const float* Kc, const float* Vc, int cstride, int npast, int t0,
                                                 const bf16_t* Zb  , int zstride, int qcol, int kcol, int vcol,
                                                 bf16_t* out  , const LAS float* sbias, LAS float* qs, LAS float* wb, int lane) {
    lane = opaque_tid() & 63;
#pragma unroll
    for (int t = 0; t < NQ; ++t) qs[t * 64 + lane] = bf2f(Zb[(size_t)(t0 + t) * zstride + qcol + lane]);
    LDS_WAIT();
    const int total = npast + 16, nblk = (total + 63) >> 6;
    float o[NQ], carry[NQ], mrun[NQ], lsum[NQ];
#pragma unroll
    for (int t = 0; t < NQ; ++t) { o[t] = 0.f; carry[t] = 0.f; mrun[t] = -1e30f; lsum[t] = 0.f; }
    for (int j = nblk - 1; j >= 0; --j) {
        const int kidx = 64 * j + lane; const bool vkey = kidx < total;
        const bool past = 64 * j < npast;
        const int nk = (total - 64 * j) < 64 ? (total - 64 * j) : 64;
        float kr[64];
        float vv[16];
        if (past) {
            const f32x4* p = (const f32x4*)(Kc + (size_t)kidx * cstride);
#pragma unroll
            for (int i = 0; i < 16; ++i) { const f32x4 v = p[i]; kr[4 * i] = v.x; kr[4 * i + 1] = v.y; kr[4 * i + 2] = v.z; kr[4 * i + 3] = v.w; }
            const float* vp = Vc + (size_t)(64 * j) * cstride + lane;
#pragma unroll
            for (int i = 0; i < 16; ++i) vv[i] = __builtin_nontemporal_load(vp + (size_t)i * cstride);
        } else {
            const int tt = vkey ? (kidx - npast) : 0;
            const u32x4* p = (const u32x4*)(Zb + (size_t)tt * zstride + kcol);
#pragma unroll
            for (int i = 0; i < 8; ++i) { const u32x4 v = p[i]; kr[8 * i] = bflo(v.x); kr[8 * i + 1] = bfhi(v.x); kr[8 * i + 2] = bflo(v.y); kr[8 * i + 3] = bfhi(v.y);
                kr[8 * i + 4] = bflo(v.z); kr[8 * i + 5] = bfhi(v.z); kr[8 * i + 6] = bflo(v.w); kr[8 * i + 7] = bfhi(v.w); }
#pragma unroll
            for (int i = 0; i < 16; ++i) vv[i] = bf2f(Zb[(size_t)i * zstride + vcol + lane]);
        }
#pragma unroll
        for (int t = 0; t < NQ; ++t) {
            float z = 0.f;
#pragma unroll
            for (int i = 0; i < 16; ++i) { const f32x4 qv = *(const LAS f32x4*)(qs + t * 64 + 4 * i); z += qv.x * kr[4 * i] + qv.y * kr[4 * i + 1] + qv.z * kr[4 * i + 2] + qv.w * kr[4 * i + 3]; }
            z *= 0.125f;
            float wv;
            if (MODE == 0) {
                const bool valid = vkey && (kidx < npast + t0 + t);
                const float lbv = log_sigmoid_f(z); const float lkv = valid ? (lbv - z) : 0.f;
                float x = lkv;
#pragma unroll
                for (int off = 1; off < 64; off <<= 1) { const float y = __shfl_down(x, off); if (lane + off < 64) x += y; }
                wv = valid ? __expf(lbv + carry[t] + (x - lkv)) : 0.f;
                carry[t] += __shfl(x, 0);
            } else {
                int rel = npast + t0 + t - kidx; rel = rel > 128 ? 128 : rel; rel = rel < -63 ? -63 : rel;
                const float s = vkey ? (z + sbias[rel + 63]) : -1e30f;
                const float mnew = fmaxf(mrun[t], wave_max(s)), alpha = __expf(mrun[t] - mnew);
                wv = vkey ? __expf(s - mnew) : 0.f;
                lsum[t] = lsum[t] * alpha + wv; o[t] *= alpha; mrun[t] = mnew;
            }
            wb[lane * NQ + t] = wv;
        }
        LDS_WAIT();
        for (int k0 = 0; k0 < nk; k0 += 16) {
            float vn[16];
            if (past && k0 + 16 < nk) { const float* vp = Vc + (size_t)(64 * j + k0 + 16) * cstride + lane;
#pragma unroll
                for (int i = 0; i < 16; ++i) vn[i] = __builtin_nontemporal_load(vp + (size_t)i * cstride); }
            else {
#pragma unroll
                for (int i = 0; i < 16; ++i) vn[i] = 0.f; }
#pragma unroll
            for (int i = 0; i < 16; ++i) {
#pragma unroll
                for (int t = 0; t < NQ; ++t) o[t] += wb[(k0 + i) * NQ + t] * vv[i];
            }
#pragma unroll
            for (int i = 0; i < 16; ++i) vv[i] = vn[i];
        }
        LDS_WAIT();
        if (MODE == 0 && SB_EARLY_EXIT) {
            bool done = true;
#pragma unroll
            for (int t = 0; t < NQ; ++t) done = done && (carry[t] < SB_EXIT_THR);
            if (done) break;
        }
    }
#pragma unroll
    for (int t = 0; t < NQ; ++t) {
        float val = o[t];
        if (MODE == 1) val = val / wave_sum(lsum[t]);
        out[(size_t)(t0 + t) * DM + lane] = f2bf(val);
    }
}

struct GlaWs { float* UTp; float* UTs; float* OI; bf16_t* SPT; bf16_t* QG; float* Dg; };
__device__ __forceinline__ float* gla_ut(const GlaWs& W, int ug) { return ug < 1024 ? W.UTp + (size_t)ug * 8192 : W.UTs + (size_t)(ug - 1024) * 8192; }
__device__ __forceinline__ void gla_stage1(const bf16_t* Z, const bf16_t* VT, const float* wgate, const float* bgate, const GlaWs& W, int ug, int par, LAS unsigned char* lds) {
    LAS unsigned char* base = lds + par * 36864;
    LAS bf16_t* qg = (LAS bf16_t*)(base);
    LAS bf16_t* kg = (LAS bf16_t*)(base + 9216);
    LAS bf16_t* kdT = (LAS bf16_t*)(base + 18432);
    LAS bf16_t* att = (LAS bf16_t*)(base + 27648);
    const int tid = opaque_tid(), lane = tid & 63, w = __builtin_amdgcn_readfirstlane(tid >> 6), l16 = lane & 15, q4 = lane >> 4;
    int h, nvalid; size_t row0;
    if (ug < 1024) { const int bh = ug >> 5, c = ug & 31; h = bh & 3; row0 = (size_t)(bh >> 2) * TP + 64 * c; nvalid = 64; }
    else { const int bh = ug - 1024; h = bh & 3; row0 = (size_t)MPROMPT + (bh >> 2) * TSAMP; nvalid = 16; }
    const bool valid = lane < nvalid;
    const bf16_t* zr = Z + (row0 + (valid ? lane : 0)) * NZ_AB;
    const u32x4 g0 = *(const u32x4*)(zr + 3072), g1 = *(const u32x4*)(zr + 3080);
    const u32x4 q8 = *(const u32x4*)(zr + 1536 + h * 64 + 8 * w), k8 = *(const u32x4*)(zr + 1792 + h * 64 + 8 * w);
    bf16x8 vt[2];
#pragma unroll
    for (int ks = 0; ks < 2; ++ks) vt[ks] = *(const bf16x8*)(VT + (size_t)(512 + h * 128 + 16 * w + l16) * MP + row0 + 32 * ks + 8 * q4);
    float gl[16];
    gl[0] = bflo(g0.x); gl[1] = bfhi(g0.x); gl[2] = bflo(g0.y); gl[3] = bfhi(g0.y); gl[4] = bflo(g0.z); gl[5] = bfhi(g0.z); gl[6] = bflo(g0.w); gl[7] = bfhi(g0.w);
    gl[8] = bflo(g1.x); gl[9] = bfhi(g1.x); gl[10] = bflo(g1.y); gl[11] = bfhi(g1.y); gl[12] = bflo(g1.z); gl[13] = bfhi(g1.z); gl[14] = bflo(g1.w); gl[15] = bfhi(g1.w);
    float bb[8], tot[8];
    {
        const float* wgp = wgate + h * 64 + 8 * w; const float* bgp = bgate + h * 64 + 8 * w;
        float pre[8];
#pragma unroll
        for (int e = 0; e < 8; ++e) pre[e] = bgp[e];
#pragma unroll
        for (int j = 0; j < 16; ++j)
#pragma unroll
            for (int e = 0; e < 8; ++e) pre[e] += gl[j] * wgp[j * 256 + e];
#pragma unroll
        for (int e = 0; e < 8; ++e) {
            float x = valid ? log_sigmoid_f(pre[e]) * (1.f / 16.f) : 0.f;
#pragma unroll
            for (int off = 1; off < 64; off <<= 1) { const float y = __shfl_up(x, off); if (lane >= off) x += y; }
            bb[e] = x; tot[e] = __shfl(x, 63);
        }
    }
    {
        const float qf[8] = {bflo(q8.x), bfhi(q8.x), bflo(q8.y), bfhi(q8.y), bflo(q8.z), bfhi(q8.z), bflo(q8.w), bfhi(q8.w)};
        const float kf[8] = {bflo(k8.x), bfhi(k8.x), bflo(k8.y), bfhi(k8.y), bflo(k8.z), bfhi(k8.z), bflo(k8.w), bfhi(k8.w)};
        float qo[8], ko[8];
#pragma unroll
        for (int e = 0; e < 8; ++e) { const float qv = valid ? qf[e] : 0.f, kv = valid ? kf[e] : 0.f; qo[e] = qv * 0.125f * __expf(bb[e]); ko[e] = kv * __expf(-bb[e]);
            kdT[(8 * w + e) * 72 + lane] = f2bf(kv * __expf(tot[e] - bb[e])); }
        u32x4 qp, kp; qp.x = cvt_pk_bf16(qo[0], qo[1]); qp.y = cvt_pk_bf16(qo[2], qo[3]); qp.z = cvt_pk_bf16(qo[4], qo[5]); qp.w = cvt_pk_bf16(qo[6], qo[7]);
        kp.x = cvt_pk_bf16(ko[0], ko[1]); kp.y = cvt_pk_bf16(ko[2], ko[3]); kp.z = cvt_pk_bf16(ko[4], ko[5]); kp.w = cvt_pk_bf16(ko[6], ko[7]);
        *(LAS u32x4*)(qg + lane * 72 + 8 * w) = qp; *(LAS u32x4*)(kg + lane * 72 + 8 * w) = kp;
        *(u32x4*)(W.QG + (size_t)ug * 4096 + lane * 64 + 8 * w) = qp;
        if (lane == 63) { float* dp = W.Dg + (size_t)ug * 64 + 8 * w;
#pragma unroll
            for (int e = 0; e < 8; ++e) dp[e] = tot[e]; }
    }
    __syncthreads();
    {
        const int rt = w >> 1;
#pragma unroll
        for (int cc = 0; cc < 2; ++cc) { const int ct = 2 * (w & 1) + cc; f32x4 acc = (f32x4){0.f, 0.f, 0.f, 0.f};
#pragma unroll
            for (int ks = 0; ks < 2; ++ks) { const bf16x8 A = *(const LAS bf16x8*)(qg + (16 * rt + l16) * 72 + 32 * ks + 8 * q4), B = *(const LAS bf16x8*)(kg + (16 * ct + l16) * 72 + 32 * ks + 8 * q4); acc = MFMA16(A, B, acc); }
#pragma unroll
            for (int r = 0; r < 4; ++r) { const int t = 16 * rt + 4 * q4 + r, s2 = 16 * ct + l16; att[t * 72 + s2] = f2bf(s2 <= t ? acc[r] : 0.f); } }
    }
    __syncthreads();
    {
        float* oi = W.OI + (size_t)ug * 8192 + tid;
#pragma unroll
        for (int rt = 0; rt < 4; ++rt) { f32x4 o = (f32x4){0.f, 0.f, 0.f, 0.f};
#pragma unroll
            for (int ks = 0; ks < 2; ++ks) { const bf16x8 A1 = *(const LAS bf16x8*)(att + (16 * rt + l16) * 72 + 32 * ks + 8 * q4); o = MFMA16(A1, vt[ks], o); }
#pragma unroll
            for (int r = 0; r < 4; ++r) oi[(rt * 4 + r) * 512] = o[r]; }
        float* ut = gla_ut(W, ug);
#pragma unroll
        for (int ct = 0; ct < 4; ++ct) { f32x4 u = (f32x4){0.f, 0.f, 0.f, 0.f};
#pragma unroll
            for (int ks = 0; ks < 2; ++ks) { const bf16x8 Bk = *(const LAS bf16x8*)(kdT + (16 * ct + l16) * 72 + 32 * ks + 8 * q4); u = MFMA16(vt[ks], Bk, u); }
#pragma unroll
            for (int r = 0; r < 4; ++r) ut[(16 * w + 4 * q4 + r) * 64 + 16 * ct + l16] = u[r]; }
    }
}
__device__ __forceinline__ void gla_scan(const GlaWs& W, const float* state_in, float* bsp, float* bss, int gt, int NT) {
    for (int item = gt; item < 64 * 8192; item += NT) {
        const int bh64 = item >> 13, e = item & 8191, dk = e & 63, dv = e >> 6;
        if (bh64 < 32) {
            float uu[32], dd[32];
#pragma unroll
            for (int c = 0; c < 32; ++c) { const int ug = bh64 * 32 + c; uu[c] = __builtin_nontemporal_load(W.UTp + (size_t)ug * 8192 + e); dd[c] = W.Dg[(size_t)ug * 64 + dk]; }
            float S = 0.f;
#pragma unroll
            for (int c = 0; c < 32; ++c) { const int ug = bh64 * 32 + c; W.SPT[(size_t)ug * 8192 + e] = f2bf(S); S = __expf(dd[c]) * S + uu[c]; }
            bsp[(size_t)bh64 * 8192 + dk * 128 + dv] = S;
        } else {
            const int bh = bh64 - 32, ug = 1024 + bh; const float S0 = state_in[(size_t)bh * 8192 + dk * 128 + dv];
            W.SPT[(size_t)ug * 8192 + e] = f2bf(S0);
            bss[(size_t)bh * 8192 + dk * 128 + dv] = __expf(W.Dg[(size_t)ug * 64 + dk]) * S0 + W.UTs[(size_t)bh * 8192 + e];
        }
    }
}
__device__ __forceinline__ void gla_stage3_item(const bf16_t* Z, bf16_t* CAT, const float* ggla, const GlaWs& W, int ug, int rt) {
    const int lane = opaque_tid() & 63, l16 = lane & 15, q4 = lane >> 4;
    int h, nvalid; size_t row0;
    if (ug < 1024) { const int bh = ug >> 5, c = ug & 31; h = bh & 3; row0 = (size_t)(bh >> 2) * TP + 64 * c; nvalid = 64; }
    else { const int bh = ug - 1024; h = bh & 3; row0 = (size_t)MPROMPT + (bh >> 2) * TSAMP; nvalid = 16; }
    if (16 * rt >= nvalid) return;
    const float* oi = W.OI + (size_t)ug * 8192 + (rt * 4) * 512 + lane;
    f32x4 o[8];
#pragma unroll
    for (int w = 0; w < 8; ++w)
#pragma unroll
        for (int r = 0; r < 4; ++r) o[w][r] = __builtin_nontemporal_load(oi + r * 512 + w * 64);
    bf16x8 A2[2];
#pragma unroll
    for (int ks = 0; ks < 2; ++ks) A2[ks] = *(const bf16x8*)(W.QG + (size_t)ug * 4096 + (16 * rt + l16) * 64 + 32 * ks + 8 * q4);
    float rr[8][4];
#pragma unroll
    for (int w = 0; w < 8; ++w)
#pragma unroll
        for (int r = 0; r < 4; ++r) rr[w][r] = bf2f(Z[(row0 + 16 * rt + 4 * q4 + r) * NZ_AB + 2560 + h * 128 + 16 * w + l16]);
#pragma unroll
    for (int w = 0; w < 8; ++w)
#pragma unroll
        for (int ks = 0; ks < 2; ++ks) { const bf16x8 B2 = *(const bf16x8*)(W.SPT + (size_t)ug * 8192 + (16 * w + l16) * 64 + 32 * ks + 8 * q4); o[w] = MFMA16(A2[ks], B2, o[w]); }
    float rstd[4];
#pragma unroll
    for (int r = 0; r < 4; ++r) { float ss = 0.f;
#pragma unroll
        for (int w = 0; w < 8; ++w) ss += o[w][r] * o[w][r];
        ss += __shfl_xor(ss, 1); ss += __shfl_xor(ss, 2); ss += __shfl_xor(ss, 4); ss += __shfl_xor(ss, 8);
        rstd[r] = rsqrtf(ss * (1.f / 128.f) + EPS); }
#pragma unroll
    for (int w = 0; w < 8; ++w) { const float gg = ggla[h * 128 + 16 * w + l16];
#pragma unroll
        for (int r = 0; r < 4; ++r) { const float rv = rr[w][r];
            CAT[(row0 + 16 * rt + 4 * q4 + r) * DM + 512 + h * 128 + 16 * w + l16] = f2bf(o[w][r] * rstd[r] * gg * rv * __builtin_amdgcn_rcpf(1.f + __expf(-rv))); } }
}

#define XB_TMO      128
#define XB_XCNT(j)  (256  + 64 * (j))
#define XB_XSUB(j)  (1280 + 64 * (j))
#define XB_XGEN(j)  (2304 + 64 * (j))
#define XB_TOP      3328
#define XB_TOPGEN   3392
#define XCD_BAR_WORDS 3456
#define XB_SPIN_CAP (1u << 22)
__device__ __forceinline__ unsigned xb_ld(unsigned* p)              { return __hip_atomic_load(p, __ATOMIC_RELAXED, __HIP_MEMORY_SCOPE_AGENT); }
__device__ __forceinline__ unsigned xb_add(unsigned* p, unsigned v) { return __hip_atomic_fetch_add(p, v, __ATOMIC_RELAXED, __HIP_MEMORY_SCOPE_AGENT); }
__device__ __forceinline__ unsigned xb_xcc_id() { return (unsigned)__builtin_amdgcn_s_getreg((3 << 11) | 20) & 0xFu; }
#define XB_SPIN(cond, bar) do { unsigned _sp = 0; while (cond) { __builtin_amdgcn_s_sleep(1); \
    if ((++_sp & 255u) == 0u) { if (xb_ld(&(bar)[XB_TMO])) break; if (_sp > XB_SPIN_CAP) { atomicAdd(&(bar)[XB_TMO], 1u); break; } } } } while (0)
struct XcdBarrier { unsigned* bar; unsigned x; volatile LAS unsigned* st; };
__device__ __forceinline__ XcdBarrier xcd_barrier_post(unsigned* bar, volatile LAS unsigned* st) {
    XcdBarrier b; b.bar = bar; b.x = xb_xcc_id(); b.st = st;
    if (opaque_tid() == 0) (void)xb_add(&bar[XB_XCNT(b.x)], 1u);
    return b;
}
__device__ __forceinline__ void xcd_barrier_complete(unsigned* bar, unsigned x, unsigned& nloc, unsigned& nx) {
    const unsigned G = gridDim.x * gridDim.y * gridDim.z;
    unsigned sum, cnt, mine, sp = 0u;
    for (;;) {
        sum = 0u; cnt = 0u; mine = 0u;
#pragma unroll
        for (unsigned j = 0; j < 16; ++j) { const unsigned c = xb_ld(&bar[XB_XCNT(j)]); sum += c; cnt += (c > 0u) ? 1u : 0u; mine = (j == x) ? c : mine; }
        if (sum == G) break;
        __builtin_amdgcn_s_sleep(1);
        if ((++sp & 255u) == 0u) { if (xb_ld(&bar[XB_TMO])) break; if (sp > XB_SPIN_CAP) { atomicAdd(&bar[XB_TMO], 1u); break; } }
    }
    nloc = mine > 0u ? mine : 1u; nx = cnt > 0u ? cnt : 1u;
}
__device__ __forceinline__ void xcd_barrier(const XcdBarrier& b) {
    asm volatile("s_waitcnt vmcnt(0)" ::: "memory");
    __syncthreads();
    if (opaque_tid() == 0) {
        unsigned* bar = b.bar;
        __builtin_amdgcn_s_waitcnt(0);
        unsigned nloc = b.st[0], nx = b.st[1];
        if (nloc == 0u) { xcd_barrier_complete(bar, b.x, nloc, nx); b.st[0] = nloc; b.st[1] = nx; }
        const unsigned old = xb_add(&bar[XB_XSUB(b.x)], 1u);
        const unsigned gen = old / nloc;
        if (old + 1u == (gen + 1u) * nloc) {
            __builtin_amdgcn_fence(__ATOMIC_RELEASE, "agent");
            asm volatile("s_waitcnt vmcnt(0)" ::: "memory");
            const unsigned og = xb_add(&bar[XB_TOP], 1u);
            const unsigned tg = og / nx;
            if (og + 1u == (tg + 1u) * nx) xb_add(&bar[XB_TOPGEN], 1u);
            else XB_SPIN(xb_ld(&bar[XB_TOPGEN]) == tg, bar);
            __builtin_amdgcn_fence(__ATOMIC_ACQUIRE, "agent");
            xb_add(&bar[XB_XGEN(b.x)], 1u);
            asm volatile("s_waitcnt vmcnt(0)" ::: "memory");
        } else {
            XB_SPIN(xb_ld(&bar[XB_XGEN(b.x)]) == gen, bar);
            __builtin_amdgcn_fence(__ATOMIC_ACQUIRE, "agent");
            asm volatile("s_waitcnt vmcnt(0)" ::: "memory");
        }
    }
    __syncthreads();
}

constexpr int LDS_SLOT = 131072;
constexpr int LDS_BIAS = 131072 + 256;
__device__ __forceinline__ int next_unit(unsigned* ctr, LAS int* slot) {
    __syncthreads();
    if (opaque_tid() == 0) *slot = (int)atomicAdd(ctr, 1u);
    __syncthreads();
    return *slot;
}

__global__ void __launch_bounds__(512, 2) fwd_megakernel(Args a_unused) {
    extern __shared__ __attribute__((aligned(16))) unsigned char lds_raw[];
    LAS unsigned char* lds = (LAS unsigned char*)lds_raw;
    cg::grid_group grid = cg::this_grid();
    const int tid = opaque_tid(), lane = tid & 63, wave = __builtin_amdgcn_readfirstlane(tid >> 6);
    const int G = gridDim.x, gw = blockIdx.x * 8 + wave, NGW = G * 8;
#define PHASE_ARGS() const CAS4 Args& a = fresh_args(); unsigned char* ws = a.ws; unsigned* ctr = (unsigned*)(ws + WS_CTL); float* X = (float*)(ws + WS_X); bf16_t* H = (bf16_t*)(ws + WS_H); \
    bf16_t* Z = (bf16_t*)(ws + WS_Z); bf16_t* Gh = (bf16_t*)(ws + WS_Z); bf16_t* CAT = (bf16_t*)(ws + WS_CAT); bf16_t* VT = (bf16_t*)(ws + WS_VT); \
    (void)ctr; (void)X; (void)H; (void)Z; (void)Gh; (void)CAT; (void)VT
    LAS int* slot = (LAS int*)(lds + LDS_SLOT);
    LAS float* sbias = (LAS float*)(lds + LDS_BIAS);

    unsigned* barw;
    volatile LAS unsigned* bst = (volatile LAS unsigned*)(lds + LDS_SLOT + 16);
    {
    PHASE_ARGS();
    barw = ctr + 8192;
    if (tid < 2) bst[tid] = 0u;
    if (blockIdx.x == 0) { if (tid < 64) ctr[tid * 64] = 0u; for (int i = tid; i < XCD_BAR_WORDS; i += 512) barw[i] = 0u; }
    prologue_weights(a, lds, gw, NGW, wave, lane);
    norm_phase(a.in[I_XP], a.in[I_XS], X, a.in[I_GMIX], H, nullptr, 0, true, gw, NGW, lane);
    }
    grid.sync();
    const XcdBarrier xbar = xcd_barrier_post(barw, bst);
#define GRID_BAR() xcd_barrier(xbar)

#pragma nounroll
    for (int layer = 0; layer < 4; ++layer) {
        const int li = layer >> 1;
        if (layer > 0) { PHASE_ARGS(); norm_phase(nullptr, nullptr, X, a.in[I_GMIX] + layer * DM, H, (const float*)(ws + WS_PART), 11, false, gw, NGW, lane); GRID_BAR(); }
        if ((layer & 1) == 0) {
            {
                PHASE_ARGS();
                pg8::Gemm g{H, (const bf16_t*)(ws + WS_WIN + li * SZ_WIN), MP, NZ_AB, DM}; pg8::StaticOrder S; S.init(MPROMPT, NZ_AB, DM, 1, G, (int)blockIdx.x);
                EpiInAB E{Z, VT, a.out + O_AKP + (size_t)li * MPROMPT * 512, a.out + O_AVP + (size_t)li * MPROMPT * 512, a.out + O_AKS + (size_t)li * MSAMP * 512, a.out + O_AVS + (size_t)li * MSAMP * 512};
                pg8::gemm_phase<EpiInAB>(lds, g, S, E);
            }
            GRID_BAR();
            for (int rep = 0; rep <= REP_MIX_AB; ++rep) {
                PHASE_ARGS();
                unsigned* c = ctr + 64 * (layer + 8 * rep);
                const float* wgate = a.in[I_WGATE] + (size_t)li * 16 * 256; const float* bgate = a.in[I_BGATE] + li * 256; const float* ggla = a.in[I_GGLA] + li * 512;
                const GlaWs W{(float*)(ws + WS_H), (float*)(ws + WS_GLA_UTS), (float*)(ws + WS_GLA_OI), (bf16_t*)(ws + WS_GLA_SPT), (bf16_t*)(ws + WS_GLA_QG), (float*)(ws + WS_GLA_D)};
                { int par = 0; for (int ug = blockIdx.x; ug < 1056; ug += G, par ^= 1) gla_stage1(Z, VT, wgate, bgate, W, ug, par, lds); }
                for (;;) {
                    const int u = next_unit(c, slot);
                    if (u >= 544) break;
                    if (u < 32) { const int it = u * 8 + wave, bh = it >> 2, b = bh >> 3, h = bh & 7, t0 = (it & 3) * 4;
                        const size_t cb = ((size_t)(li * NB + b) * PAST) * 512 + h * 64;
                        sample_attn_item<0, 4>(a.in[I_CAK] + cb, a.in[I_CAV] + cb, 512, PAST, t0, Z + (size_t)(MPROMPT + b * TSAMP) * NZ_AB, NZ_AB, h * 64, 512 + h * 64, 1024 + h * 64,
                                            CAT + (size_t)(MPROMPT + b * TSAMP) * DM + h * 64, sbias, (LAS float*)(lds + wave * 16384), (LAS float*)(lds + wave * 16384 + 4096), lane);
                    } else { const int v = u - 32, qb = 7 - (v >> 6), bh = v & 63;
                        sb_prompt_unit(Z, VT, CAT, lds, bh >> 3, bh & 7, qb, wave);
                    }
                }
                GRID_BAR();
                gla_scan(W, a.in[I_SB] + (size_t)li * 32 * 8192, a.out + O_BSP + (size_t)li * 32 * 8192, a.out + O_BSS + (size_t)li * 32 * 8192, (int)blockIdx.x * 512 + opaque_tid(), G * 512);
                GRID_BAR();
                for (int it = gw; it < 1056 * 4; it += NGW) gla_stage3_item(Z, CAT, ggla, W, it >> 2, it & 3);
                if (rep < REP_MIX_AB) GRID_BAR();
            }
            GRID_BAR();
            {
                PHASE_ARGS();
                pg8::Gemm g{CAT, (const bf16_t*)(ws + WS_WOAB + li * SZ_WO), MP, DM, DM}; pg8::StaticOrder S; S.init(MPROMPT, DM, DM, 4, G, (int)blockIdx.x);
                EpiResid E{X, (float*)(ws + WS_PART)}; pg8::gemm_phase<EpiResid>(lds, g, S, E);
            }
            GRID_BAR();
        } else {
            {
                PHASE_ARGS();
                pg8::Gemm g{H, (const bf16_t*)(ws + WS_WQKV + li * SZ_WQKV), MP, NZ_C, DM}; pg8::StaticOrder S; S.init(MPROMPT, NZ_C, DM, 1, G, (int)blockIdx.x);
                EpiInC E{Z, VT, a.out + O_CKP + (size_t)li * NB * CWIN * 1024, a.out + O_CVP + (size_t)li * NB * CWIN * 1024, a.out + O_CKS + (size_t)li * MSAMP * 1024, a.out + O_CVS + (size_t)li * MSAMP * 1024};
                pg8::gemm_phase<EpiInC>(lds, g, S, E);
            }
            GRID_BAR();
            for (int rep = 0; rep <= REP_MIX_C; ++rep) {
                PHASE_ARGS();
                unsigned* c = ctr + 64 * (layer + 8 * rep);
                const float* rel = a.in[I_REL] + (size_t)li * 16 * 192;
                for (;;) {
                    const int u = next_unit(c, slot);
                    if (u >= 1088) break;
                    if (u >= 64) { const int v = u - 64;
                        const int qb = v < 768 ? 2 + v % 6 : (v < 896 ? 1 : 0), bh = v < 768 ? v / 6 : (v < 896 ? v - 768 : v - 896), b = bh >> 4, h = bh & 15;
                        { const int t2 = opaque_tid(); for (int i = t2; i < 768; i += 512) sbias[i] = rel[h * 192 + (i < 191 ? i : 191)] * 1.44269504f; }
                        __syncthreads();
                        band_prompt_unit(Z, VT, CAT, sbias, lds, b, h, qb, wave);
                    } else { const int it = u * 8 + wave, bh = it >> 2, b = bh >> 4, h = bh & 15, t0 = (it & 3) * 4;
                        LAS float* wbias = (LAS float*)(lds + wave * 16384 + 12288);
                        { const int l2 = opaque_tid() & 63; for (int i = l2; i < 192; i += 64) wbias[i] = rel[h * 192 + i]; }
                        LDS_WAIT();
                        const size_t cb = ((size_t)(li * NB + b) * CWIN) * 1024 + h * 64;
                        sample_attn_item<1, 4>(a.in[I_CCK] + cb, a.in[I_CCV] + cb, 1024, CWIN, t0, Z + (size_t)(MPROMPT + b * TSAMP) * NZ_C, NZ_C, h * 64, 1024 + h * 64, 2048 + h * 64,
                                            CAT + (size_t)(MPROMPT + b * TSAMP) * DM + h * 64, wbias, (LAS float*)(lds + wave * 16384), (LAS float*)(lds + wave * 16384 + 4096), lane);
                    }
                }
                if (rep < REP_MIX_C) GRID_BAR();
            }
            GRID_BAR();
            {
                PHASE_ARGS();
                pg8::Gemm g{CAT, (const bf16_t*)(ws + WS_WOC + li * SZ_WO), MP, DM, DM}; pg8::StaticOrder S; S.init(MPROMPT, DM, DM, 4, G, (int)blockIdx.x);
                EpiResid E{X, (float*)(ws + WS_PART)}; pg8::gemm_phase<EpiResid>(lds, g, S, E);
            }
            GRID_BAR();
        }
        { PHASE_ARGS(); norm_phase(nullptr, nullptr, X, a.in[I_GFFN] + layer * DM, H, (const float*)(ws + WS_PART), 4, false, gw, NGW, lane); }
        GRID_BAR();
        {
            PHASE_ARGS();
            pg8::Gemm g{H, (const bf16_t*)(ws + WS_WGU + layer * SZ_WGU), MP, NGU, DM}; pg8::StaticOrder S; S.init(MPROMPT, NGU, DM, 1, G, (int)blockIdx.x);
            EpiSwiglu E{Gh};
            for (int rep = 0; rep <= REP_UP; ++rep) { pg8::gemm_phase<EpiSwiglu>(lds, g, S, E); if (rep < REP_UP) GRID_BAR(); }
        }
        GRID_BAR();
        {
            PHASE_ARGS();
            pg8::Gemm g{Gh, (const bf16_t*)(ws + WS_WD + layer * SZ_WD), MP, DM, DFF}; pg8::StaticOrder S; S.init(MPROMPT, DM, DFF, 11, G, (int)blockIdx.x);
            EpiResid E{X, (float*)(ws + WS_PART)}; pg8::gemm_phase<EpiResid>(lds, g, S, E);
        }
        GRID_BAR();
    }
    { PHASE_ARGS(); final_norm_phase(X, a.in[I_GFIN], a.out + O_YP, (const float*)(ws + WS_PART), 11, gw, NGW, lane); }
}

extern "C" void kernel_launch(void* const* d_in, const int* in_sizes, int n_in, void* d_out, int out_size, void* d_ws, size_t ws_size, hipStream_t stream) {
    static int grid = 0;
    if (grid == 0) {
        if (n_in != 21 || (size_t)out_size != O_END || ws_size < WS_END) { fprintf(stderr, "kernel_launch: unexpected shapes (n_in %d, out %d vs %zu, ws %zu vs %zu)\n", n_in, out_size, (size_t)O_END, ws_size, (size_t)WS_END); grid = -1; return; }
        int dev = 0, cus = 0, per_cu = 0;
        hipGetDevice(&dev); hipDeviceGetAttribute(&cus, hipDeviceAttributeMultiprocessorCount, dev);
        if (hipFuncSetAttribute((const void*)fwd_megakernel, hipFuncAttributeMaxDynamicSharedMemorySize, LDS_BYTES) != hipSuccess) { fprintf(stderr, "kernel_launch: hipFuncSetAttribute failed\n"); grid = -1; return; }
        if (hipOccupancyMaxActiveBlocksPerMultiprocessor(&per_cu, (const void*)fwd_megakernel, 512, LDS_BYTES) != hipSuccess || per_cu < 1) { fprintf(stderr, "kernel_launch: occupancy query says %d\n", per_cu); per_cu = 1; }
        (void)hipGetLastError();
        grid = cus * per_cu;
    }
    if (grid < 0) return;
    Args a{};
    for (int i = 0; i < 21; ++i) a.in[i] = (const float*)d_in[i];
    a.out = (float*)d_out; a.ws = (unsigned char*)d_ws;
    void* args[] = {&a};
    hipError_t e = hipLaunchCooperativeKernel((const void*)fwd_megakernel, dim3(grid), dim3(512), args, LDS_BYTES, stream);
    if (e != hipSuccess) fprintf(stderr, "cooperative launch failed: %s (grid %d)\n", hipGetErrorString(e), grid);
}
```

```cpp
#include <hip/hip_runtime.h>
#include <hip/hip_cooperative_groups.h>
#include <cstdio>
#include <cstdint>
namespace cg = cooperative_groups;

#define LAS __attribute__((address_space(3)))
typedef unsigned short bf16_t;
typedef short bf16x8 __attribute__((ext_vector_type(8)));
typedef float f32x4 __attribute__((ext_vector_type(4)));
typedef float f32x16 __attribute__((ext_vector_type(16)));
typedef unsigned u32x4 __attribute__((ext_vector_type(4)));
typedef unsigned u32x2 __attribute__((ext_vector_type(2)));

constexpr int DM = 1024, TP = 2048, NB = 8, MPROMPT = NB * TP, TSAMP = 16, MSAMP = NB * TSAMP, MREAL = MPROMPT + MSAMP, MP = 16640;
constexpr int PAST = 2048, CWIN = 512;
constexpr int NZ_AB = 3328, NZ_C = 3072, DFF = 2816, NGU = 2 * DFF, AB_IN = 3088;
constexpr float EPS = 1e-6f;
constexpr bool SB_EARLY_EXIT = true;
constexpr float SB_EXIT_THR = -104.0f;

constexpr size_t O_YP = 0, O_YS = O_YP + (size_t)MPROMPT * DM, O_AKP = O_YS + (size_t)MSAMP * DM, O_AVP = O_AKP + (size_t)2 * MPROMPT * 512,
                 O_AKS = O_AVP + (size_t)2 * MPROMPT * 512, O_AVS = O_AKS + (size_t)2 * MSAMP * 512, O_BSP = O_AVS + (size_t)2 * MSAMP * 512,
                 O_BSS = O_BSP + (size_t)2 * NB * 4 * 64 * 128, O_CKP = O_BSS + (size_t)2 * NB * 4 * 64 * 128, O_CVP = O_CKP + (size_t)2 * NB * CWIN * 1024,
                 O_CKS = O_CVP + (size_t)2 * NB * CWIN * 1024, O_CVS = O_CKS + (size_t)2 * MSAMP * 1024, O_END = O_CVS + (size_t)2 * MSAMP * 1024;

constexpr size_t al256(size_t x) { return (x + 255) & ~(size_t)255; }
constexpr size_t WS_CTL = 0, WS_WIN = 1u << 20;
constexpr size_t SZ_WIN = (size_t)NZ_AB * DM * 2, SZ_WO = (size_t)DM * DM * 2, SZ_WQKV = (size_t)NZ_C * DM * 2, SZ_WGU = (size_t)NGU * DM * 2, SZ_WD = (size_t)DM * DFF * 2;
constexpr size_t WS_WOAB = WS_WIN + 2 * SZ_WIN, WS_WQKV = WS_WOAB + 2 * SZ_WO, WS_WOC = WS_WQKV + 2 * SZ_WQKV, WS_WGU = WS_WOC + 2 * SZ_WO, WS_WD = WS_WGU + 4 * SZ_WGU;
constexpr size_t WS_X = al256(WS_WD + 4 * SZ_WD), WS_H = WS_X + (size_t)MP * DM * 4, WS_Z = WS_H + (size_t)MP * DM * 2, WS_CAT = WS_Z + (size_t)MP * NZ_AB * 2,
                 WS_VT = WS_CAT + (size_t)MP * DM * 2, WS_GLA_OI = WS_VT + (size_t)1024 * MP * 2, WS_GLA_SPT = WS_GLA_OI + (size_t)1056 * 32768,
                 WS_GLA_QG = WS_GLA_SPT + (size_t)1056 * 16384, WS_GLA_D = WS_GLA_QG + (size_t)1056 * 8192, WS_GLA_UTS = WS_GLA_D + (size_t)1056 * 256, WS_PART = WS_GLA_UTS + (size_t)32 * 32768, WS_END = WS_PART + (size_t)11 * MSAMP * DM * 4;
static_assert((size_t)1024 * 32768 <= (size_t)MP * DM * 2, "prompt U^T images overlay H");

#ifndef REP_MIX_AB
#define REP_MIX_AB 0
#endif
#ifndef REP_MIX_C
#define REP_MIX_C 0
#endif
#ifndef REP_UP
#define REP_UP 0
#endif
constexpr int LDS_BYTES = 147456;

__device__ __forceinline__ unsigned cvt_pk_bf16(float lo, float hi) { unsigned r; asm volatile("v_cvt_pk_bf16_f32 %0, %1, %2" : "=v"(r) : "v"(lo), "v"(hi)); return r; }
__device__ __forceinline__ bf16_t f2bf(float f) { return (bf16_t)(cvt_pk_bf16(f, 0.f) & 0xffffu); }
__device__ __forceinline__ float bf2f(bf16_t v) { return __uint_as_float((unsigned)v << 16); }
__device__ __forceinline__ float bflo(unsigned v) { return __uint_as_float(v << 16); }
__device__ __forceinline__ float bfhi(unsigned v) { return __uint_as_float(v & 0xffff0000u); }
__device__ __forceinline__ float wave_sum(float v) {
#pragma unroll
    for (int o = 1; o < 64; o <<= 1) v += __shfl_xor(v, o);
    return v;
}
__device__ __forceinline__ float wave_max(float v) {
#pragma unroll
    for (int o = 1; o < 64; o <<= 1) v = fmaxf(v, __shfl_xor(v, o));
    return v;
}
__device__ __forceinline__ float log_sigmoid_f(float z) { return fminf(z, 0.f) - 0.69314718f * __builtin_amdgcn_logf(1.f + __expf(-fabsf(z))); }
__device__ __forceinline__ int crow(int r, int hi) { return (r & 3) + 8 * (r >> 2) + 4 * hi; }
#define LDS_WAIT() asm volatile("s_waitcnt lgkmcnt(0)" ::: "memory")
__device__ __forceinline__ int opaque_tid() { int t = threadIdx.x; asm volatile("" : "+v"(t)); return t; }

namespace pg8 {
constexpr int BM = 256, BK = 64, HALF = 128, HTB = HALF * BK * 2, STAGE_BYTES = 8 * HTB, NXCD = 8, WGM = 8;
__host__ __device__ __forceinline__ int lds_byte(int r, int c) { const int st = (r >> 4) * 2 + (c >> 5), rr = r & 15, cc = c & 31, ob = rr * 64 + cc * 2; return st * 1024 + (ob ^ (((ob >> 9) & 1) << 5)); }
__host__ __device__ __forceinline__ void stage_rc(int b, int& R, int& C) { const int st = b / 1024, sb = b % 1024, swz = sb ^ (((sb >> 9) & 1) << 5); R = (st >> 1) * 16 + swz / 64; C = (st & 1) * 32 + (swz % 64) / 2; }
__host__ __device__ __forceinline__ int perm32(int rho) { const int n = rho >> 4, i = rho & 15; return 8 * (i >> 2) + 4 * n + (i & 3); }
struct Unit { int pm, pn, kt0, nkt, split; };
struct Gemm { const bf16_t* A; const bf16_t* Bt; int M, N, K; };
struct StaticOrder {
    int nM, nN, nmain, nwg, G, c, ktiles, nsplit;
    __host__ __device__ void init(int Mmain, int N, int K, int nsplit_, int G_, int c_) { nM = Mmain / BM; nN = N / BM; nmain = nM * nN; ktiles = K / BK; nsplit = nsplit_; nwg = nmain + nN * nsplit; G = G_; c = c_; }
    __host__ __device__ bool next(int i, Unit& u) const {
        const long L = (long)i * G + c; if (L >= nwg) return false;
        if (L < nmain) {
            int wgid = (int)L; { const int q = nmain / NXCD, r = nmain % NXCD, xcd = wgid % NXCD, off = wgid / NXCD; wgid = (xcd < r ? xcd * (q + 1) : r * (q + 1) + (xcd - r) * q) + off; }
            const int nig = WGM * nN, gid = wgid / nig, fm = gid * WGM, gsz = (nM - fm) < WGM ? (nM - fm) : WGM;
            u.pm = fm + ((wgid % nig) % gsz); u.pn = (wgid % nig) / gsz; u.kt0 = 0; u.nkt = ktiles; u.split = 0;
        } else {
            const int s2 = (int)L - nmain; u.pm = nM; u.pn = s2 % nN; u.nkt = ktiles / nsplit; u.kt0 = (s2 / nN) * u.nkt; u.split = nsplit > 1 ? 1 : 0;
        }
        return true;
    }
};
template <class Epi>
__device__ __forceinline__ void gemm_phase(LAS unsigned char* lds, const Gemm g, const StaticOrder& S, const Epi& E) {
    const int tid = opaque_tid(), wid = __builtin_amdgcn_readfirstlane(tid >> 6), lane = tid & 63, wr = wid >> 2, wc = wid & 3, fr = lane & 15, fq = lane >> 4;
    const int K = g.K;
    unsigned voffA[2], voffB[2];
#pragma unroll
    for (int i = 0; i < 2; ++i) { int R, C; stage_rc(tid * 16 + i * 8192, R, C); const int Rb = Epi::PERM ? ((R & ~31) + perm32(R & 31)) : R;
        voffA[i] = (unsigned)(R * K + C) * 2u; voffB[i] = (unsigned)(Rb * K + C) * 2u; }
    const size_t kstep = (size_t)(BK * 2);
    const size_t hstep = (size_t)HALF * K * 2;
    const size_t tstep = 2 * hstep;
    const unsigned ldsw = (unsigned)wid * 1024u;
    const int aoff = lds_byte(wr * 64 + fr, fq * 8), boff = lds_byte(wc * 32 + fr, fq * 8);
#define PG8_SA(b, h) (((b) * 2 + (h)) * HTB)
#define PG8_SB(b, h) ((4 + (b) * 2 + (h)) * HTB)
#define PG8_STAGE(bufoff, gbase, voff) do { _Pragma("unroll") for (int _i = 0; _i < 2; ++_i) \
        __builtin_amdgcn_global_load_lds((const unsigned*)((const char*)(gbase) + (voff)[_i]), (LAS unsigned*)(lds + (bufoff) + ldsw + _i * 8192), 16, 0, 0); } while (0)
#define PG8_LDA(dst, b, h) do { _Pragma("unroll") for (int m = 0; m < 4; ++m) _Pragma("unroll") for (int k = 0; k < 2; ++k) dst[m][k] = *(const LAS bf16x8*)(lds + PG8_SA(b, h) + aoff + m * 2048 + k * 1024); } while (0)
#define PG8_LDB(dst, b, h) do { _Pragma("unroll") for (int n = 0; n < 2; ++n) _Pragma("unroll") for (int k = 0; k < 2; ++k) dst[n][k] = *(const LAS bf16x8*)(lds + PG8_SB(b, h) + boff + n * 2048 + k * 1024); } while (0)
#define PG8_MMA(ai, bj, At, Bt) do { __builtin_amdgcn_s_setprio(1); _Pragma("unroll") for (int m = 0; m < 4; ++m) _Pragma("unroll") for (int n = 0; n < 2; ++n) _Pragma("unroll") for (int k = 0; k < 2; ++k) \
        acc[ai][bj][m][n] = __builtin_amdgcn_mfma_f32_16x16x32_bf16(Bt[n][k], At[m][k], acc[ai][bj][m][n], 0, 0, 0); __builtin_amdgcn_s_setprio(0); } while (0)
#define PG8_WAIT_V(n) asm volatile("s_waitcnt vmcnt(" #n ")" ::: "memory")
#define PG8_WAIT_L(n) asm volatile("s_waitcnt lgkmcnt(" #n ")" ::: "memory")
#define PG8_BAR __builtin_amdgcn_s_barrier()
#define PG8_SCHED __builtin_amdgcn_sched_barrier(0)
    Unit cur, nxt; int ui = 0;
    if (!S.next(0, cur)) return;
    f32x4 acc[2][2][4][2];
    if constexpr (Epi::HAS_INIT) E.init(acc, cur, wr, wc, fr, fq);
    else {
#pragma unroll
    for (int a = 0; a < 2; ++a)
#pragma unroll
        for (int b = 0; b < 2; ++b)
#pragma unroll
            for (int m = 0; m < 4; ++m)
#pragma unroll
                for (int n = 0; n < 2; ++n) acc[a][b][m][n] = (f32x4){0.f, 0.f, 0.f, 0.f};
    }
    bf16x8 At[4][2], B0[2][2], B1[2][2];
    const char* cA = (const char*)g.A + (size_t)cur.pm * tstep + (size_t)cur.kt0 * kstep; const char* cB = (const char*)g.Bt + (size_t)cur.pn * tstep + (size_t)cur.kt0 * kstep;
    PG8_STAGE(PG8_SB(0, 0), cB, voffB); PG8_STAGE(PG8_SB(0, 1), cB + hstep, voffB); PG8_STAGE(PG8_SA(0, 0), cA, voffA); PG8_STAGE(PG8_SA(0, 1), cA + hstep, voffA);
    if (wr == 1) PG8_BAR;
    PG8_WAIT_V(2); PG8_BAR;
    PG8_STAGE(PG8_SB(1, 0), cB + kstep, voffB); PG8_STAGE(PG8_SA(1, 0), cA + kstep, voffA); PG8_STAGE(PG8_SB(1, 1), cB + hstep + kstep, voffB);
    PG8_WAIT_V(6); PG8_BAR;
    for (;;) {
        const bool has_next = S.next(ui + 1, nxt);
        const char* nA = has_next ? (const char*)g.A + (size_t)nxt.pm * tstep + (size_t)nxt.kt0 * kstep : cA; const char* nB = has_next ? (const char*)g.Bt + (size_t)nxt.pn * tstep + (size_t)nxt.kt0 * kstep : cB;
        const int nt = cur.nkt;
        for (int t = 0; t < nt; t += 2) {
            const bool last = (t == nt - 2);
            const char* a1 = cA + (size_t)(t + 1) * kstep;
            const char* a2 = last ? nA : cA + (size_t)(t + 2) * kstep; const char* b2 = last ? nB : cB + (size_t)(t + 2) * kstep;
            const char* a3 = a2 + kstep; const char* b3 = b2 + kstep;
            PG8_LDB(B0, 0, 0); PG8_LDB(B1, 0, 1); PG8_SCHED; PG8_LDA(At, 0, 0); PG8_STAGE(PG8_SA(1, 1), a1 + hstep, voffA);
            PG8_WAIT_V(8); PG8_WAIT_L(0); PG8_BAR; PG8_MMA(0, 0, At, B0); PG8_MMA(0, 1, At, B1); PG8_BAR; PG8_SCHED;
            PG8_LDA(At, 0, 1); PG8_STAGE(PG8_SB(0, 0), b2, voffB); PG8_STAGE(PG8_SB(0, 1), b2 + hstep, voffB); PG8_STAGE(PG8_SA(0, 0), a2, voffA);
            PG8_WAIT_V(8); PG8_WAIT_L(0); PG8_BAR; PG8_MMA(1, 0, At, B0); PG8_MMA(1, 1, At, B1); PG8_BAR; PG8_SCHED;
            PG8_LDB(B0, 1, 0); PG8_LDB(B1, 1, 1); PG8_SCHED; PG8_LDA(At, 1, 0); PG8_STAGE(PG8_SA(0, 1), a2 + hstep, voffA);
            PG8_WAIT_V(8); PG8_WAIT_L(0); PG8_BAR; PG8_MMA(0, 0, At, B0); PG8_MMA(0, 1, At, B1); PG8_BAR; PG8_SCHED;
            PG8_LDA(At, 1, 1); PG8_STAGE(PG8_SB(1, 0), b3, voffB); PG8_STAGE(PG8_SB(1, 1), b3 + hstep, voffB); PG8_STAGE(PG8_SA(1, 0), a3, voffA);
            PG8_WAIT_V(8); PG8_WAIT_L(0); PG8_BAR; PG8_MMA(1, 0, At, B0); PG8_MMA(1, 1, At, B1); PG8_BAR; PG8_SCHED;
        }
        if (wr == 0) PG8_BAR;
        E(acc, cur, wr, wc, fr, fq);
        if (!has_next) break;
        if constexpr (Epi::HAS_INIT) E.init(acc, nxt, wr, wc, fr, fq);
        else {
#pragma unroll
        for (int a = 0; a < 2; ++a)
#pragma unroll
            for (int b = 0; b < 2; ++b)
#pragma unroll
                for (int m = 0; m < 4; ++m)
#pragma unroll
                    for (int n = 0; n < 2; ++n) acc[a][b][m][n] = (f32x4){0.f, 0.f, 0.f, 0.f};
        }
        cur = nxt; cA = nA; cB = nB; ++ui;
        if (wr == 1) PG8_BAR;
    }
    PG8_WAIT_V(0);
    PG8_BAR;
#undef PG8_SA
#undef PG8_SB
#undef PG8_STAGE
#undef PG8_LDA
#undef PG8_LDB
#undef PG8_MMA
#undef PG8_WAIT_V
#undef PG8_WAIT_L
#undef PG8_BAR
#undef PG8_SCHED
}
}

struct EpiInAB {
    static constexpr bool PERM = true, HAS_INIT = false;
    bf16_t* Z; bf16_t* VT; float* akp; float* avp; float* aks; float* avs;
    __device__ __forceinline__ void operator()(const f32x4 (&acc)[2][2][4][2], const pg8::Unit& u, int wr, int wc, int fr, int fq) const {
        const int pn = u.pn, colb = pn * 256 + wc * 32 + 8 * fq;
        const bool isk = (pn == 2 || pn == 3), isv = (pn == 4 || pn == 5), isvb = (pn == 8 || pn == 9);
#pragma unroll
        for (int ai = 0; ai < 2; ++ai)
#pragma unroll
            for (int m = 0; m < 4; ++m) {
                const int row = u.pm * 256 + ai * 128 + wr * 64 + m * 16 + fr;
#pragma unroll
                for (int bj = 0; bj < 2; ++bj) {
                    const int c = colb + bj * 128; const f32x4 v0 = acc[ai][bj][m][0], v1 = acc[ai][bj][m][1];
                    u32x4 w; w.x = cvt_pk_bf16(v0[0], v0[1]); w.y = cvt_pk_bf16(v0[2], v0[3]); w.z = cvt_pk_bf16(v1[0], v1[1]); w.w = cvt_pk_bf16(v1[2], v1[3]);
                    *(u32x4*)(Z + (size_t)row * NZ_AB + c) = w;
                    if (isk || isv) {
                        const int cc = c - (isk ? 512 : 1024);
                        float* dst = nullptr;
                        if (row < MPROMPT) dst = (isk ? akp : avp) + (size_t)row * 512 + cc;
                        else if (row < MREAL) dst = (isk ? aks : avs) + (size_t)(row - MPROMPT) * 512 + cc;
                        if (dst) { __builtin_nontemporal_store(v0, (f32x4*)dst); __builtin_nontemporal_store(v1, (f32x4*)(dst + 4)); }
                    }
                    if (isv || isvb) {
                        const int vc = isv ? (c - 1024) : (512 + c - 2048);
                        bf16_t* p = VT + (size_t)vc * MP + row;
                        p[0] = (bf16_t)(w.x & 0xffffu); p[(size_t)MP] = (bf16_t)(w.x >> 16); p[(size_t)2 * MP] = (bf16_t)(w.y & 0xffffu); p[(size_t)3 * MP] = (bf16_t)(w.y >> 16);
                        p[(size_t)4 * MP] = (bf16_t)(w.z & 0xffffu); p[(size_t)5 * MP] = (bf16_t)(w.z >> 16); p[(size_t)6 * MP] = (bf16_t)(w.w & 0xffffu); p[(size_t)7 * MP] = (bf16_t)(w.w >> 16);
                    }
                }
            }
    }
};
struct EpiInC {
    static constexpr bool PERM = true, HAS_INIT = false;
    bf16_t* Z; bf16_t* VT; float* ckp; float* cvp; float* cks; float* cvs;
    __device__ __forceinline__ void operator()(const f32x4 (&acc)[2][2][4][2], const pg8::Unit& u, int wr, int wc, int fr, int fq) const {
        const int pn = u.pn, colb = pn * 256 + wc * 32 + 8 * fq;
        const bool isk = (pn >= 4 && pn < 8), isv = (pn >= 8);
#pragma unroll
        for (int ai = 0; ai < 2; ++ai)
#pragma unroll
            for (int m = 0; m < 4; ++m) {
                const int row = u.pm * 256 + ai * 128 + wr * 64 + m * 16 + fr;
#pragma unroll
                for (int bj = 0; bj < 2; ++bj) {
                    const int c = colb + bj * 128; const f32x4 v0 = acc[ai][bj][m][0], v1 = acc[ai][bj][m][1];
                    u32x4 w; w.x = cvt_pk_bf16(v0[0], v0[1]); w.y = cvt_pk_bf16(v0[2], v0[3]); w.z = cvt_pk_bf16(v1[0], v1[1]); w.w = cvt_pk_bf16(v1[2], v1[3]);
                    *(u32x4*)(Z + (size_t)row * NZ_C + c) = w;
                    if (isk || isv) {
                        const int cc = c - (isk ? 1024 : 2048);
                        float* dst = nullptr;
                        if (row < MPROMPT) { const int t = row & (TP - 1), b = row >> 11; if (t >= TP - CWIN) dst = (isk ? ckp : cvp) + ((size_t)b * CWIN + (t - (TP - CWIN))) * 1024 + cc; }
                        else if (row < MREAL) dst = (isk ? cks : cvs) + (size_t)(row - MPROMPT) * 1024 + cc;
                        if (dst) { __builtin_nontemporal_store(v0, (f32x4*)dst); __builtin_nontemporal_store(v1, (f32x4*)(dst + 4)); }
                    }
                    if (isv) {
                        const int vc = c - 2048;
                        bf16_t* p = VT + (size_t)vc * MP + row;
                        p[0] = (bf16_t)(w.x & 0xffffu); p[(size_t)MP] = (bf16_t)(w.x >> 16); p[(size_t)2 * MP] = (bf16_t)(w.y & 0xffffu); p[(size_t)3 * MP] = (bf16_t)(w.y >> 16);
                        p[(size_t)4 * MP] = (bf16_t)(w.z & 0xffffu); p[(size_t)5 * MP] = (bf16_t)(w.z >> 16); p[(size_t)6 * MP] = (bf16_t)(w.w & 0xffffu); p[(size_t)7 * MP] = (bf16_t)(w.w >> 16);
                    }
                }
            }
    }
};
struct EpiResid {
    static constexpr bool PERM = false, HAS_INIT = true;
    float* X; float* P;
    __device__ __forceinline__ void init(f32x4 (&acc)[2][2][4][2], const pg8::Unit& u, int wr, int wc, int fr, int fq) const {
        const int col0 = u.pn * 256 + wc * 32 + 4 * fq;
        if (u.split) {
#pragma unroll
            for (int ai = 0; ai < 2; ++ai)
#pragma unroll
                for (int bj = 0; bj < 2; ++bj)
#pragma unroll
                    for (int m = 0; m < 4; ++m)
#pragma unroll
                        for (int n = 0; n < 2; ++n) acc[ai][bj][m][n] = (f32x4){0.f, 0.f, 0.f, 0.f};
            return;
        }
#pragma unroll
        for (int ai = 0; ai < 2; ++ai)
#pragma unroll
            for (int m = 0; m < 4; ++m) {
                const float* rp = X + (size_t)(u.pm * 256 + ai * 128 + wr * 64 + m * 16 + fr) * DM + col0;
#pragma unroll
                for (int bj = 0; bj < 2; ++bj)
#pragma unroll
                    for (int n = 0; n < 2; ++n) acc[ai][bj][m][n] = __builtin_nontemporal_load((const f32x4*)(rp + bj * 128 + n * 16));
            }
    }
    __device__ __forceinline__ void operator()(const f32x4 (&acc)[2][2][4][2], const pg8::Unit& u, int wr, int wc, int fr, int fq) const {
        const int col0 = u.pn * 256 + wc * 32 + 4 * fq;
        if (u.split) {
            float* pb = P + (size_t)(u.kt0 / u.nkt) * MSAMP * DM;
#pragma unroll
            for (int m = 0; m < 4; ++m) {
                float* rp = pb + (size_t)(wr * 64 + m * 16 + fr) * DM + col0;
#pragma unroll
                for (int bj = 0; bj < 2; ++bj)
#pragma unroll
                    for (int n = 0; n < 2; ++n) *(f32x4*)(rp + bj * 128 + n * 16) = acc[0][bj][m][n];
            }
            return;
        }
#pragma unroll
        for (int ai = 0; ai < 2; ++ai)
#pragma unroll
            for (int m = 0; m < 4; ++m) {
                float* rp = X + (size_t)(u.pm * 256 + ai * 128 + wr * 64 + m * 16 + fr) * DM + col0;
#pragma unroll
                for (int bj = 0; bj < 2; ++bj)
#pragma unroll
                    for (int n = 0; n < 2; ++n) *(f32x4*)(rp + bj * 128 + n * 16) = acc[ai][bj][m][n];
            }
    }
};
struct EpiSwiglu {
    static constexpr bool PERM = true, HAS_INIT = false;
    bf16_t* G;
    __device__ __forceinline__ void operator()(const f32x4 (&acc)[2][2][4][2], const pg8::Unit& u, int wr, int wc, int fr, int fq) const {
        const int col0 = u.pn * 128 + wc * 32 + 8 * fq;
#pragma unroll
        for (int ai = 0; ai < 2; ++ai)
#pragma unroll
            for (int m = 0; m < 4; ++m) {
                const int row = u.pm * 256 + ai * 128 + wr * 64 + m * 16 + fr;
                float o[8];
#pragma unroll
                for (int n = 0; n < 2; ++n)
#pragma unroll
                    for (int j = 0; j < 4; ++j) { const float g = acc[ai][0][m][n][j], uu = acc[ai][1][m][n][j]; o[n * 4 + j] = g * __builtin_amdgcn_rcpf(1.f + __expf(-g)) * uu; }
                u32x4 w; w.x = cvt_pk_bf16(o[0], o[1]); w.y = cvt_pk_bf16(o[2], o[3]); w.z = cvt_pk_bf16(o[4], o[5]); w.w = cvt_pk_bf16(o[6], o[7]);
                *(u32x4*)(G + (size_t)row * DFF + col0) = w;
            }
    }
};

__device__ __forceinline__ void tr_item(const float* W, int K, int Nsrc, int c0, int nvalid, bf16_t* WT, int r0, int k0, LAS float* scr, int lane) {
    const int cc = lane & 31;
    float tv[32];
#pragma unroll
    for (int i = 0; i < 32; ++i) { const int kk = 2 * i + (lane >> 5); tv[i] = (cc < nvalid) ? __builtin_nontemporal_load(W + (size_t)(k0 + kk) * Nsrc + c0 + cc) : 0.f; }
#pragma unroll
    for (int i = 0; i < 32; ++i) { const int kk = 2 * i + (lane >> 5); scr[kk * 33 + cc] = tv[i]; }
    LDS_WAIT();
    const int c = lane & 7;
#pragma unroll
    for (int j = 0; j < 4; ++j) { const int n = (lane >> 3) + 8 * j; const LAS float* s = scr + (8 * c) * 33 + n;
        u32x4 o; o.x = cvt_pk_bf16(s[0 * 33], s[1 * 33]); o.y = cvt_pk_bf16(s[2 * 33], s[3 * 33]); o.z = cvt_pk_bf16(s[4 * 33], s[5 * 33]); o.w = cvt_pk_bf16(s[6 * 33], s[7 * 33]);
        *(u32x4*)(WT + (size_t)(r0 + n) * K + k0 + 8 * c) = o; }
    LDS_WAIT();
}

struct Args { const float* in[21]; float* out; unsigned char* ws; };
enum { I_XP = 0, I_XS, I_CAK, I_CAV, I_SB, I_CCK, I_CCV, I_GMIX, I_GFFN, I_WIN, I_WGATE, I_BGATE, I_GGLA, I_WOAB, I_WQKV, I_REL, I_WOC, I_WFG, I_WFU, I_WFD, I_GFIN };

#define CAS4 __attribute__((address_space(4)))
__device__ __forceinline__ const CAS4 Args& fresh_args() { const CAS4 Args* p = (const CAS4 Args*)__builtin_amdgcn_kernarg_segment_ptr(); asm volatile("" : "+s"(p)); return *p; }

__device__ __forceinline__ void prologue_weights(const CAS4 Args& a, LAS unsigned char* lds, int gw, int NGW, int wave, int lane) {
    lane = opaque_tid() & 63;
    LAS float* scr = (LAS float*)(lds + wave * 16384);
    unsigned char* ws = a.ws;
    constexpr int KB1 = DM / 64, KB2 = DFF / 64;
    constexpr int N_IN = 2 * (NZ_AB / 32) * KB1, N_OAB = 2 * 32 * KB1, N_QKV = 2 * (NZ_C / 32) * KB1, N_OC = 2 * 32 * KB1, N_GU = 4 * (NGU / 32) * KB1, N_D = 4 * 32 * KB2;
    constexpr int NITEMS = N_IN + N_OAB + N_QKV + N_OC + N_GU + N_D;
    for (int it = gw; it < NITEMS; it += NGW) {
        int r = it;
        if (r < N_IN) { const int per = (NZ_AB / 32) * KB1, L = r / per, q = r % per, db = q / KB1, kb = q % KB1;
            int c0, nv; if (db < 80) { c0 = 32 * db; nv = 32; } else if (db < 96) { c0 = 2576 + 32 * (db - 80); nv = 32; } else if (db == 96) { c0 = 2560; nv = 16; } else { c0 = 0; nv = 0; }
            tr_item(a.in[I_WIN] + (size_t)L * DM * AB_IN, DM, AB_IN, c0, nv, (bf16_t*)(ws + WS_WIN + L * SZ_WIN), 32 * db, 64 * kb, scr, lane); continue; } r -= N_IN;
        if (r < N_OAB) { const int per = 32 * KB1, L = r / per, q = r % per, db = q / KB1, kb = q % KB1;
            tr_item(a.in[I_WOAB] + (size_t)L * DM * DM, DM, DM, 32 * db, 32, (bf16_t*)(ws + WS_WOAB + L * SZ_WO), 32 * db, 64 * kb, scr, lane); continue; } r -= N_OAB;
        if (r < N_QKV) { const int per = (NZ_C / 32) * KB1, L = r / per, q = r % per, db = q / KB1, kb = q % KB1;
            tr_item(a.in[I_WQKV] + (size_t)L * DM * NZ_C, DM, NZ_C, 32 * db, 32, (bf16_t*)(ws + WS_WQKV + L * SZ_WQKV), 32 * db, 64 * kb, scr, lane); continue; } r -= N_QKV;
        if (r < N_OC) { const int per = 32 * KB1, L = r / per, q = r % per, db = q / KB1, kb = q % KB1;
            tr_item(a.in[I_WOC] + (size_t)L * DM * DM, DM, DM, 32 * db, 32, (bf16_t*)(ws + WS_WOC + L * SZ_WO), 32 * db, 64 * kb, scr, lane); continue; } r -= N_OC;
        if (r < N_GU) { const int per = (NGU / 32) * KB1, L = r / per, q = r % per, db = q / KB1, kb = q % KB1, tile = db >> 3, wi = db & 7;
            const float* src = (wi < 4 ? a.in[I_WFG] : a.in[I_WFU]) + (size_t)L * DM * DFF;
            tr_item(src, DM, DFF, 128 * tile + 32 * (wi & 3), 32, (bf16_t*)(ws + WS_WGU + L * SZ_WGU), 32 * db, 64 * kb, scr, lane); continue; } r -= N_GU;
        { const int per = 32 * KB2, L = r / per, q = r % per, db = q / KB2, kb = q % KB2;
            tr_item(a.in[I_WFD] + (size_t)L * DFF * DM, DFF, DM, 32 * db, 32, (bf16_t*)(ws + WS_WD + L * SZ_WD), 32 * db, 64 * kb, scr, lane); }
    }
}

__device__ __forceinline__ void norm_phase(const float* xp, const float* xs, float* X, const float* g, bf16_t* H, const float* P, int nsplit, bool first, int gw, int NGW, int lane) {
    lane = opaque_tid() & 63;
    f32x4 gv[4];
#pragma unroll
    for (int j = 0; j < 4; ++j) gv[j] = *((const f32x4*)g + lane + 64 * j);
    for (int row = gw; row < MP; row += NGW) {
        const float* src = X + (size_t)row * DM;
        if (first) src = row < MPROMPT ? xp + (size_t)row * DM : (row < MREAL ? xs + (size_t)(row - MPROMPT) * DM : nullptr);
        f32x4 v[4];
#pragma unroll
        for (int j = 0; j < 4; ++j) v[j] = src ? __builtin_nontemporal_load((const f32x4*)src + lane + 64 * j) : (f32x4){0.f, 0.f, 0.f, 0.f};
        const bool fold = !first && row >= MPROMPT && row < MREAL;
        if (fold) {
            for (int s2 = 0; s2 < nsplit; s2 += 4) { f32x4 t[4][4];
#pragma unroll
                for (int k = 0; k < 4; ++k) { const int sk = (s2 + k < nsplit) ? s2 + k : s2; const f32x4* pp = (const f32x4*)(P + ((size_t)sk * MSAMP + (row - MPROMPT)) * DM) + lane;
#pragma unroll
                    for (int j = 0; j < 4; ++j) t[k][j] = pp[64 * j]; }
#pragma unroll
                for (int k = 0; k < 4; ++k) if (s2 + k < nsplit) {
#pragma unroll
                    for (int j = 0; j < 4; ++j) v[j] = v[j] + t[k][j]; } }
        }
        float s = 0.f;
#pragma unroll
        for (int j = 0; j < 4; ++j) s += (v[j].x * v[j].x + v[j].y * v[j].y) + (v[j].z * v[j].z + v[j].w * v[j].w);
        const float rs = rsqrtf(wave_sum(s) * (1.f / DM) + EPS);
        u32x2* o = (u32x2*)(H + (size_t)row * DM) + lane;
#pragma unroll
        for (int j = 0; j < 4; ++j) { const f32x4 y = v[j] * rs * gv[j]; u32x2 w; w.x = cvt_pk_bf16(y.x, y.y); w.y = cvt_pk_bf16(y.z, y.w); o[64 * j] = w;
            if (first || fold) *((f32x4*)(X + (size_t)row * DM) + lane + 64 * j) = v[j]; }
    }
}
__device__ __forceinline__ void final_norm_phase(const float* X, const float* g, float* Y, const float* P, int nsplit, int gw, int NGW, int lane) {
    lane = opaque_tid() & 63;
    f32x4 gv[4];
#pragma unroll
    for (int j = 0; j < 4; ++j) gv[j] = *((const f32x4*)g + lane + 64 * j);
    for (int row = gw; row < MREAL; row += NGW) {
        const float* src = X + (size_t)row * DM;
        f32x4 v[4];
#pragma unroll
        for (int j = 0; j < 4; ++j) v[j] = __builtin_nontemporal_load((const f32x4*)src + lane + 64 * j);
        if (row >= MPROMPT) {
            for (int s2 = 0; s2 < nsplit; s2 += 4) { f32x4 t[4][4];
#pragma unroll
                for (int k = 0; k < 4; ++k) { const int sk = (s2 + k < nsplit) ? s2 + k : s2; const f32x4* pp = (const f32x4*)(P + ((size_t)sk * MSAMP + (row - MPROMPT)) * DM) + lane;
#pragma unroll
                    for (int j = 0; j < 4; ++j) t[k][j] = pp[64 * j]; }
#pragma unroll
                for (int k = 0; k < 4; ++k) if (s2 + k < nsplit) {
#pragma unroll
                    for (int j = 0; j < 4; ++j) v[j] = v[j] + t[k][j]; } }
        }
        float s = 0.f;
#pragma unroll
        for (int j = 0; j < 4; ++j) s += (v[j].x * v[j].x + v[j].y * v[j].y) + (v[j].z * v[j].z + v[j].w * v[j].w);
        const float rs = rsqrtf(wave_sum(s) * (1.f / DM) + EPS);
#pragma unroll
        for (int j = 0; j < 4; ++j) __builtin_nontemporal_store(v[j] * rs * gv[j], (f32x4*)(Y + (size_t)row * DM) + lane + 64 * j);
    }
}

#define MFMA32(a, b, c) __builtin_amdgcn_mfma_f32_32x32x16_bf16(a, b, c, 0, 0, 0)
#define MFMA16(a, b, c) __builtin_amdgcn_mfma_f32_16x16x32_bf16(a, b, c, 0, 0, 0)

__device__ __forceinline__ bf16x8 ld_vt(const bf16_t* p) {
    const u32x2 lo = *(const u32x2*)p, hi = *(const u32x2*)(p + 8);
    u32x4 t; t.x = lo.x; t.y = lo.y; t.z = hi.x; t.w = hi.y; return __builtin_bit_cast(bf16x8, t);
}
__device__ __forceinline__ bf16x8 pack8(const float* w) {
    u32x4 t; t.x = cvt_pk_bf16(w[0], w[1]); t.y = cvt_pk_bf16(w[2], w[3]); t.z = cvt_pk_bf16(w[4], w[5]); t.w = cvt_pk_bf16(w[6], w[7]); return __builtin_bit_cast(bf16x8, t);
}
__device__ __forceinline__ void store_ot(const f32x16& o0, const f32x16& o1, float sc, bf16_t* dst  , int hi) {
#pragma unroll
    for (int mt = 0; mt < 2; ++mt)
#pragma unroll
        for (int g = 0; g < 4; ++g) { const f32x16& o = mt ? o1 : o0; u32x2 w; w.x = cvt_pk_bf16(o[4 * g] * sc, o[4 * g + 1] * sc); w.y = cvt_pk_bf16(o[4 * g + 2] * sc, o[4 * g + 3] * sc);
            *(u32x2*)(dst + 32 * mt + 8 * g + 4 * hi) = w; }
}

__device__ __forceinline__ void sb_prompt_unit(const bf16_t* Z, const bf16_t* VT, bf16_t* CAT, LAS unsigned char* lds, int b, int h, int qb, int wave) {
    const int tid = opaque_tid(), lane = tid & 63;
    const int n = lane & 31, hi = lane >> 5;
    const int q0 = qb * 256 + wave * 32, qpos = q0 + n, ktd = q0 >> 5;
    const size_t rowb = (size_t)b * TP;
    bf16x8 bq[4];
#pragma unroll
    for (int s = 0; s < 4; ++s) bq[s] = *(const bf16x8*)(Z + (rowb + qpos) * NZ_AB + h * 64 + 16 * s + 8 * hi);
    f32x16 o0, o1;
#pragma unroll
    for (int r = 0; r < 16; ++r) { o0[r] = 0.f; o1[r] = 0.f; }
    float carry = 0.f; bool done = false;
    const int srow = tid >> 3, sseg = tid & 7, soff = srow * 144 + sseg * 16;
    const bf16_t* kgp = Z + (rowb + srow) * NZ_AB + 512 + h * 64 + sseg * 8;
    const bf16_t* vgp = VT + (size_t)(h * 64 + srow) * MP + rowb + sseg * 8;
    LAS int* dflag = (LAS int*)(lds + 36864);
    const int kc_first = 4 * qb + 3;
    u32x4 rk = *(const u32x4*)(kgp + (size_t)(kc_first * 64) * NZ_AB), rv = *(const u32x4*)(vgp + kc_first * 64);
    *(LAS u32x4*)(lds + soff) = rk; *(LAS u32x4*)(lds + 9216 + soff) = rv;
    __syncthreads();
    int buf = 0;
    for (int kc = kc_first; kc >= 0; --kc) {
        if (kc > 0) { rk = *(const u32x4*)(kgp + (size_t)((kc - 1) * 64) * NZ_AB); rv = *(const u32x4*)(vgp + (kc - 1) * 64); }
        const LAS unsigned char* kb = lds + buf * 18432; const LAS unsigned char* vb = kb + 9216;
#pragma unroll
        for (int half = 1; half >= 0; --half) {
            const int kt = 2 * kc + half;
            if (kt <= ktd && !done) {
                bf16x8 ak[4], av[2][2];
#pragma unroll
                for (int s = 0; s < 4; ++s) ak[s] = *(const LAS bf16x8*)(kb + (32 * half + n) * 144 + 32 * s + 16 * hi);
#pragma unroll
                for (int s2 = 0; s2 < 2; ++s2)
#pragma unroll
                    for (int mt = 0; mt < 2; ++mt) { const LAS unsigned char* p = vb + (32 * mt + n) * 144 + (32 * half + 16 * s2 + 4 * hi) * 2;
                        const u32x2 lo = *(const LAS u32x2*)p, hi2 = *(const LAS u32x2*)(p + 16); u32x4 t; t.x = lo.x; t.y = lo.y; t.z = hi2.x; t.w = hi2.y; av[s2][mt] = __builtin_bit_cast(bf16x8, t); }
                f32x16 st;
#pragma unroll
                for (int r = 0; r < 16; ++r) st[r] = 0.f;
#pragma unroll
                for (int s = 0; s < 4; ++s) st = MFMA32(ak[s], bq[s], st);
                const bool diag = (kt == ktd);
                float lb[16], lk[16];
#pragma unroll
                for (int r = 0; r < 16; ++r) { const float z2 = st[r] * 0.18033688f; const float l2 = fminf(z2, 0.f) - __builtin_amdgcn_logf(1.f + __builtin_amdgcn_exp2f(-fabsf(z2))); lb[r] = l2; lk[r] = l2 - z2; }
                if (diag) {
#pragma unroll
                    for (int r = 0; r < 16; ++r) { const int key = kt * 32 + crow(r, hi); if (key >= qpos) { lk[r] = 0.f; lb[r] = -1e30f; } }
                }
                float gs[4], pg[4];
#pragma unroll
                for (int g = 0; g < 4; ++g) { gs[g] = (lk[4 * g] + lk[4 * g + 1]) + (lk[4 * g + 2] + lk[4 * g + 3]); pg[g] = __shfl_xor(gs[g], 32); }
                float T[5]; T[4] = 0.f;
#pragma unroll
                for (int g = 3; g >= 0; --g) T[g] = T[g + 1] + (gs[g] + pg[g]);
                float w[16];
#pragma unroll
                for (int g = 0; g < 4; ++g) {
                    const float gsuf = carry + T[g + 1] + (hi == 0 ? pg[g] : 0.f);
                    const float e2 = lk[4 * g + 3], e1 = e2 + lk[4 * g + 2], e0 = e1 + lk[4 * g + 1];
                    const float af[4] = {gsuf + e0, gsuf + e1, gsuf + e2, gsuf};
#pragma unroll
                    for (int j = 0; j < 4; ++j) { const int r = 4 * g + j; w[r] = __builtin_amdgcn_exp2f(lb[r] + af[j]); }
                }
                carry += T[0];
#pragma unroll
                for (int s2 = 0; s2 < 2; ++s2) { const bf16x8 bw = pack8(w + 8 * s2); o0 = MFMA32(av[s2][0], bw, o0); o1 = MFMA32(av[s2][1], bw, o1); }
                if (SB_EARLY_EXIT && __all(carry < SB_EXIT_THR * 1.44269504f)) done = true;
            }
        }
        if (kc > 0) { const int nb = (buf ^ 1) * 18432; *(LAS u32x4*)(lds + nb + soff) = rk; *(LAS u32x4*)(lds + nb + 9216 + soff) = rv; }
        LAS int* df = dflag + (kc & 1) * 8;
        if (lane == 0) df[wave] = done ? 1 : 0;
        __syncthreads();
        const int alld = (df[0] & df[1]) & (df[2] & df[3]) & (df[4] & df[5]) & (df[6] & df[7]);
        if (alld) break;
        buf ^= 1;
    }
    store_ot(o0, o1, 1.f, CAT + (rowb + qpos) * DM + h * 64, hi);
}

__device__ __forceinline__ void band_prompt_unit(const bf16_t* Z, const bf16_t* VT, bf16_t* CAT, const LAS float* sbias, LAS unsigned char* lds, int b, int h, int qb, int wave) {
    const int tid = opaque_tid(), lane = tid & 63;
    const int n = lane & 31, hi = lane >> 5;
    const int c0 = qb * 4, cw = c0 + (wave >> 1);
    const int q0 = qb * 256 + wave * 32, qpos = q0 + n;
    const size_t rowb = (size_t)b * TP;
    bf16x8 bq[4];
#pragma unroll
    for (int s = 0; s < 4; ++s) bq[s] = *(const bf16x8*)(Z + (rowb + qpos) * NZ_C + h * 64 + 16 * s + 8 * hi);
    f32x16 o0, o1;
#pragma unroll
    for (int r = 0; r < 16; ++r) { o0[r] = 0.f; o1[r] = 0.f; }
    float mrun = -1e30f, lrun = 0.f;
    const int srow = tid >> 3, sseg = tid & 7, soff = srow * 144 + sseg * 16;
    const bf16_t* kgp = Z + (rowb + srow) * NZ_C + 1024 + h * 64 + sseg * 8;
    const bf16_t* vgp = VT + (size_t)(h * 64 + srow) * MP + rowb + sseg * 8;
    const int kc_first = (c0 >= 8) ? (c0 - 8) : 0, kc_last = c0 + 3;
    u32x4 rk = *(const u32x4*)(kgp + (size_t)(kc_first * 64) * NZ_C), rv = *(const u32x4*)(vgp + kc_first * 64);
    *(LAS u32x4*)(lds + soff) = rk; *(LAS u32x4*)(lds + 9216 + soff) = rv;
    __syncthreads();
    int buf = 0;
    for (int kc = kc_first; kc <= kc_last; ++kc) {
        if (kc < kc_last) { rk = *(const u32x4*)(kgp + (size_t)((kc + 1) * 64) * NZ_C); rv = *(const u32x4*)(vgp + (kc + 1) * 64); }
        if (kc >= cw - 8 && kc <= cw) {
            const LAS unsigned char* kb = lds + buf * 18432; const LAS unsigned char* vb = kb + 9216;
#pragma unroll
            for (int half = 0; half < 2; ++half) {
                const int kt = 2 * kc + half;
                bf16x8 ak[4], av[2][2];
#pragma unroll
                for (int s = 0; s < 4; ++s) ak[s] = *(const LAS bf16x8*)(kb + (32 * half + n) * 144 + 32 * s + 16 * hi);
#pragma unroll
                for (int s2 = 0; s2 < 2; ++s2)
#pragma unroll
                    for (int mt = 0; mt < 2; ++mt) { const LAS unsigned char* p = vb + (32 * mt + n) * 144 + (32 * half + 16 * s2 + 4 * hi) * 2;
                        const u32x2 lo = *(const LAS u32x2*)p, hi2 = *(const LAS u32x2*)(p + 16); u32x4 t; t.x = lo.x; t.y = lo.y; t.z = hi2.x; t.w = hi2.y; av[s2][mt] = __builtin_bit_cast(bf16x8, t); }
                f32x16 st;
#pragma unroll
                for (int r = 0; r < 16; ++r) st[r] = 0.f;
#pragma unroll
                for (int s = 0; s < 4; ++s) st = MFMA32(ak[s], bq[s], st);
                const LAS float* bp = sbias + (qpos + 63 - 27 - 4 * hi - 32 * kt);
                float sv[16]; float mx = -1e30f;
#pragma unroll
                for (int r = 0; r < 16; ++r) { sv[r] = st[r] * 0.18033688f + bp[27 - ((r & 3) + 8 * (r >> 2))]; mx = fmaxf(mx, sv[r]); }
                mx = fmaxf(mx, __shfl_xor(mx, 32));
                const float mnew = fmaxf(mrun, mx), alpha = __builtin_amdgcn_exp2f(mrun - mnew);
                float w[16]; float ps = 0.f;
#pragma unroll
                for (int r = 0; r < 16; ++r) { w[r] = __builtin_amdgcn_exp2f(sv[r] - mnew); ps += w[r]; }
                lrun = lrun * alpha + ps; mrun = mnew;
                if (!__all(alpha == 1.0f)) {
#pragma unroll
                    for (int r = 0; r < 16; ++r) { o0[r] *= alpha; o1[r] *= alpha; }
                }
#pragma unroll
                for (int s2 = 0; s2 < 2; ++s2) { const bf16x8 bw = pack8(w + 8 * s2); o0 = MFMA32(av[s2][0], bw, o0); o1 = MFMA32(av[s2][1], bw, o1); }
            }
        }
        if (kc < kc_last) { const int nb = (buf ^ 1) * 18432; *(LAS u32x4*)(lds + nb + soff) = rk; *(LAS u32x4*)(lds + nb + 9216 + soff) = rv; }
        __syncthreads();
        buf ^= 1;
    }
    const float l = lrun + __shfl_xor(lrun, 32);
    store_ot(o0, o1, 1.f / l, CAT + (rowb + qpos) * DM + h * 64, hi);
}

template <int MODE, int NQ>
__device__ __forceinline__ void sample_attn_item(const float* Kc, const float* Vc, int cstride, int npast, int t0,
                                                 const bf16_t* Zb  , int zstride, int qcol, int kcol, int vcol,
                                                 bf16_t* out  , const LAS float* sbias, LAS float* qs, LAS float* wb, int lane) {
    lane = opaque_tid() & 63;
#pragma unroll
    for (int t = 0; t < NQ; ++t) qs[t * 64 + lane] = bf2f(Zb[(size_t)(t0 + t) * zstride + qcol + lane]);
    LDS_WAIT();
    const int total = npast + 16, nblk = (total + 63) >> 6;
    float o[NQ], carry[NQ], mrun[NQ], lsum[NQ];
#pragma unroll
    for (int t = 0; t < NQ; ++t) { o[t] = 0.f; carry[t] = 0.f; mrun[t] = -1e30f; lsum[t] = 0.f; }
    for (int j = nblk - 1; j >= 0; --j) {
        const int kidx = 64 * j + lane; const bool vkey = kidx < total;
        const bool past = 64 * j < npast;
        const int nk = (total - 64 * j) < 64 ? (total - 64 * j) : 64;
        float kr[64];
        float vv[16];
        if (past) {
            const f32x4* p = (const f32x4*)(Kc + (size_t)kidx * cstride);
#pragma unroll
            for (int i = 0; i < 16; ++i) { const f32x4 v = p[i]; kr[4 * i] = v.x; kr[4 * i + 1] = v.y; kr[4 * i + 2] = v.z; kr[4 * i + 3] = v.w; }
            const float* vp = Vc + (size_t)(64 * j) * cstride + lane;
#pragma unroll
            for (int i = 0; i < 16; ++i) vv[i] = __builtin_nontemporal_load(vp + (size_t)i * cstride);
        } else {
            const int tt = vkey ? (kidx - npast) : 0;
            const u32x4* p = (const u32x4*)(Zb + (size_t)tt * zstride + kcol);
#pragma unroll
            for (int i = 0; i < 8; ++i) { const u32x4 v = p[i]; kr[8 * i] = bflo(v.x); kr[8 * i + 1] = bfhi(v.x); kr[8 * i + 2] = bflo(v.y); kr[8 * i + 3] = bfhi(v.y);
                kr[8 * i + 4] = bflo(v.z); kr[8 * i + 5] = bfhi(v.z); kr[8 * i + 6] = bflo(v.w); kr[8 * i + 7] = bfhi(v.w); }
#pragma unroll
            for (int i = 0; i < 16; ++i) vv[i] = bf2f(Zb[(size_t)i * zstride + vcol + lane]);
        }
#pragma unroll
        for (int t = 0; t < NQ; ++t) {
            float z = 0.f;
#pragma unroll
            for (int i = 0; i < 16; ++i) { const f32x4 qv = *(const LAS f32x4*)(qs + t * 64 + 4 * i); z += qv.x * kr[4 * i] + qv.y * kr[4 * i + 1] + qv.z * kr[4 * i + 2] + qv.w * kr[4 * i + 3]; }
            z *= 0.125f;
            float wv;
            if (MODE == 0) {
                const bool valid = vkey && (kidx < npast + t0 + t);
                const float lbv = log_sigmoid_f(z); const float lkv = valid ? (lbv - z) : 0.f;
                float x = lkv;
#pragma unroll
                for (int off = 1; off < 64; off <<= 1) { const float y = __shfl_down(x, off); if (lane + off < 64) x += y; }
                wv = valid ? __expf(lbv + carry[t] + (x - lkv)) : 0.f;
                carry[t] += __shfl(x, 0);
            } else {
                int rel = npast + t0 + t - kidx; rel = rel > 128 ? 128 : rel; rel = rel < -63 ? -63 : rel;
                const float s = vkey ? (z + sbias[rel + 63]) : -1e30f;
                const float mnew = fmaxf(mrun[t], wave_max(s)), alpha = __expf(mrun[t] - mnew);
                wv = vkey ? __expf(s - mnew) : 0.f;
                lsum[t] = lsum[t] * alpha + wv; o[t] *= alpha; mrun[t] = mnew;
            }
            wb[lane * NQ + t] = wv;
        }
        LDS_WAIT();
        for (int k0 = 0; k0 < nk; k0 += 16) {
            float vn[16];
            if (past && k0 + 16 < nk) { const float* vp = Vc + (size_t)(64 * j + k0 + 16) * cstride + lane;
#pragma unroll
                for (int i = 0; i < 16; ++i) vn[i] = __builtin_nontemporal_load(vp + (size_t)i * cstride); }
            else {
#pragma unroll
                for (int i = 0; i < 16; ++i) vn[i] = 0.f; }
#pragma unroll
            for (int i = 0; i < 16; ++i) {
#pragma unroll
                for (int t = 0; t < NQ; ++t) o[t] += wb[(k0 + i) * NQ + t] * vv[i];
            }
#pragma unroll
            for (int i = 0; i < 16; ++i) vv[i] = vn[i];
        }
        LDS_WAIT();
        if (MODE == 0 && SB_EARLY_EXIT) {
            bool done = true;
#pragma unroll
            for (int t = 0; t < NQ; ++t) done = done && (carry[t] < SB_EXIT_THR);
            if (done) break;
        }
    }
#pragma unroll
    for (int t = 0; t < NQ; ++t) {
        float val = o[t];
        if (MODE == 1) val = val / wave_sum(lsum[t]);
        out[(size_t)(t0 + t) * DM + lane] = f2bf(val);
    }
}

struct GlaWs { float* UTp; float* UTs; float* OI; bf16_t* SPT; bf16_t* QG; float* Dg; };
__device__ __forceinline__ float* gla_ut(const GlaWs& W, int ug) { return ug < 1024 ? W.UTp + (size_t)ug * 8192 : W.UTs + (size_t)(ug - 1024) * 8192; }
__device__ __forceinline__ void gla_stage1(const bf16_t* Z, const bf16_t* VT, const float* wgate, const float* bgate, const GlaWs& W, int ug, int par, LAS unsigned char* lds) {
    LAS unsigned char* base = lds + par * 36864;
    LAS bf16_t* qg = (LAS bf16_t*)(base);
    LAS bf16_t* kg = (LAS bf16_t*)(base + 9216);
    LAS bf16_t* kdT = (LAS bf16_t*)(base + 18432);
    LAS bf16_t* att = (LAS bf16_t*)(base + 27648);
    const int tid = opaque_tid(), lane = tid & 63, w = __builtin_amdgcn_readfirstlane(tid >> 6), l16 = lane & 15, q4 = lane >> 4;
    int h, nvalid; size_t row0;
    if (ug < 1024) { const int bh = ug >> 5, c = ug & 31; h = bh & 3; row0 = (size_t)(bh >> 2) * TP + 64 * c; nvalid = 64; }
    else { const int bh = ug - 1024; h = bh & 3; row0 = (size_t)MPROMPT + (bh >> 2) * TSAMP; nvalid = 16; }
    const bool valid = lane < nvalid;
    const bf16_t* zr = Z + (row0 + (valid ? lane : 0)) * NZ_AB;
    const u32x4 g0 = *(const u32x4*)(zr + 3072), g1 = *(const u32x4*)(zr + 3080);
    const u32x4 q8 = *(const u32x4*)(zr + 1536 + h * 64 + 8 * w), k8 = *(const u32x4*)(zr + 1792 + h * 64 + 8 * w);
    bf16x8 vt[2];
#pragma unroll
    for (int ks = 0; ks < 2; ++ks) vt[ks] = *(const bf16x8*)(VT + (size_t)(512 + h * 128 + 16 * w + l16) * MP + row0 + 32 * ks + 8 * q4);
    float gl[16];
    gl[0] = bflo(g0.x); gl[1] = bfhi(g0.x); gl[2] = bflo(g0.y); gl[3] = bfhi(g0.y); gl[4] = bflo(g0.z); gl[5] = bfhi(g0.z); gl[6] = bflo(g0.w); gl[7] = bfhi(g0.w);
    gl[8] = bflo(g1.x); gl[9] = bfhi(g1.x); gl[10] = bflo(g1.y); gl[11] = bfhi(g1.y); gl[12] = bflo(g1.z); gl[13] = bfhi(g1.z); gl[14] = bflo(g1.w); gl[15] = bfhi(g1.w);
    float bb[8], tot[8];
    {
        const float* wgp = wgate + h * 64 + 8 * w; const float* bgp = bgate + h * 64 + 8 * w;
        float pre[8];
#pragma unroll
        for (int e = 0; e < 8; ++e) pre[e] = bgp[e];
#pragma unroll
        for (int j = 0; j < 16; ++j)
#pragma unroll
            for (int e = 0; e < 8; ++e) pre[e] += gl[j] * wgp[j * 256 + e];
#pragma unroll
        for (int e = 0; e < 8; ++e) {
            float x = valid ? log_sigmoid_f(pre[e]) * (1.f / 16.f) : 0.f;
#pragma unroll
            for (int off = 1; off < 64; off <<= 1) { const float y = __shfl_up(x, off); if (lane >= off) x += y; }
            bb[e] = x; tot[e] = __shfl(x, 63);
        }
    }
    {
        const float qf[8] = {bflo(q8.x), bfhi(q8.x), bflo(q8.y), bfhi(q8.y), bflo(q8.z), bfhi(q8.z), bflo(q8.w), bfhi(q8.w)};
        const float kf[8] = {bflo(k8.x), bfhi(k8.x), bflo(k8.y), bfhi(k8.y), bflo(k8.z), bfhi(k8.z), bflo(k8.w), bfhi(k8.w)};
        float qo[8], ko[8];
#pragma unroll
        for (int e = 0; e < 8; ++e) { const float qv = valid ? qf[e] : 0.f, kv = valid ? kf[e] : 0.f; qo[e] = qv * 0.125f * __expf(bb[e]); ko[e] = kv * __expf(-bb[e]);
            kdT[(8 * w + e) * 72 + lane] = f2bf(kv * __expf(tot[e] - bb[e])); }
        u32x4 qp, kp; qp.x = cvt_pk_bf16(qo[0], qo[1]); qp.y = cvt_pk_bf16(qo[2], qo[3]); qp.z = cvt_pk_bf16(qo[4], qo[5]); qp.w = cvt_pk_bf16(qo[6], qo[7]);
        kp.x = cvt_pk_bf16(ko[0], ko[1]); kp.y = cvt_pk_bf16(ko[2], ko[3]); kp.z = cvt_pk_bf16(ko[4], ko[5]); kp.w = cvt_pk_bf16(ko[6], ko[7]);
        *(LAS u32x4*)(qg + lane * 72 + 8 * w) = qp; *(LAS u32x4*)(kg + lane * 72 + 8 * w) = kp;
        *(u32x4*)(W.QG + (size_t)ug * 4096 + lane * 64 + 8 * w) = qp;
        if (lane == 63) { float* dp = W.Dg + (size_t)ug * 64 + 8 * w;
#pragma unroll
            for (int e = 0; e < 8; ++e) dp[e] = tot[e]; }
    }
    __syncthreads();
    {
        const int rt = w >> 1;
#pragma unroll
        for (int cc = 0; cc < 2; ++cc) { const int ct = 2 * (w & 1) + cc; f32x4 acc = (f32x4){0.f, 0.f, 0.f, 0.f};
#pragma unroll
            for (int ks = 0; ks < 2; ++ks) { const bf16x8 A = *(const LAS bf16x8*)(qg + (16 * rt + l16) * 72 + 32 * ks + 8 * q4), B = *(const LAS bf16x8*)(kg + (16 * ct + l16) * 72 + 32 * ks + 8 * q4); acc = MFMA16(A, B, acc); }
#pragma unroll
            for (int r = 0; r < 4; ++r) { const int t = 16 * rt + 4 * q4 + r, s2 = 16 * ct + l16; att[t * 72 + s2] = f2bf(s2 <= t ? acc[r] : 0.f); } }
    }
    __syncthreads();
    {
        float* oi = W.OI + (size_t)ug * 8192 + tid;
#pragma unroll
        for (int rt = 0; rt < 4; ++rt) { f32x4 o = (f32x4){0.f, 0.f, 0.f, 0.f};
#pragma unroll
            for (int ks = 0; ks < 2; ++ks) { const bf16x8 A1 = *(const LAS bf16x8*)(att + (16 * rt + l16) * 72 + 32 * ks + 8 * q4); o = MFMA16(A1, vt[ks], o); }
#pragma unroll
            for (int r = 0; r < 4; ++r) oi[(rt * 4 + r) * 512] = o[r]; }
        float* ut = gla_ut(W, ug);
#pragma unroll
        for (int ct = 0; ct < 4; ++ct) { f32x4 u = (f32x4){0.f, 0.f, 0.f, 0.f};
#pragma unroll
            for (int ks = 0; ks < 2; ++ks) { const bf16x8 Bk = *(const LAS bf16x8*)(kdT + (16 * ct + l16) * 72 + 32 * ks + 8 * q4); u = MFMA16(vt[ks], Bk, u); }
#pragma unroll
            for (int r = 0; r < 4; ++r) ut[(16 * w + 4 * q4 + r) * 64 + 16 * ct + l16] = u[r]; }
    }
}
__device__ __forceinline__ void gla_scan(const GlaWs& W, const float* state_in, float* bsp, float* bss, int gt, int NT) {
    for (int item = gt; item < 64 * 8192; item += NT) {
        const int bh64 = item >> 13, e = item & 8191, dk = e & 63, dv = e >> 6;
        if (bh64 < 32) {
            float uu[32], dd[32];
#pragma unroll
            for (int c = 0; c < 32; ++c) { const int ug = bh64 * 32 + c; uu[c] = __builtin_nontemporal_load(W.UTp + (size_t)ug * 8192 + e); dd[c] = W.Dg[(size_t)ug * 64 + dk]; }
            float S = 0.f;
#pragma unroll
            for (int c = 0; c < 32; ++c) { const int ug = bh64 * 32 + c; W.SPT[(size_t)ug * 8192 + e] = f2bf(S); S = __expf(dd[c]) * S + uu[c]; }
            bsp[(size_t)bh64 * 8192 + dk * 128 + dv] = S;
        } else {
            const int bh = bh64 - 32, ug = 1024 + bh; const float S0 = state_in[(size_t)bh * 8192 + dk * 128 + dv];
            W.SPT[(size_t)ug * 8192 + e] = f2bf(S0);
            bss[(size_t)bh * 8192 + dk * 128 + dv] = __expf(W.Dg[(size_t)ug * 64 + dk]) * S0 + W.UTs[(size_t)bh * 8192 + e];
        }
    }
}
__device__ __forceinline__ void gla_stage3_item(const bf16_t* Z, bf16_t* CAT, const float* ggla, const GlaWs& W, int ug, int rt) {
    const int lane = opaque_tid() & 63, l16 = lane & 15, q4 = lane >> 4;
    int h, nvalid; size_t row0;
    if (ug < 1024) { const int bh = ug >> 5, c = ug & 31; h = bh & 3; row0 = (size_t)(bh >> 2) * TP + 64 * c; nvalid = 64; }
    else { const int bh = ug - 1024; h = bh & 3; row0 = (size_t)MPROMPT + (bh >> 2) * TSAMP; nvalid = 16; }
    if (16 * rt >= nvalid) return;
    const float* oi = W.OI + (size_t)ug * 8192 + (rt * 4) * 512 + lane;
    f32x4 o[8];
#pragma unroll
    for (int w = 0; w < 8; ++w)
#pragma unroll
        for (int r = 0; r < 4; ++r) o[w][r] = __builtin_nontemporal_load(oi + r * 512 + w * 64);
    bf16x8 A2[2];
#pragma unroll
    for (int ks = 0; ks < 2; ++ks) A2[ks] = *(const bf16x8*)(W.QG + (size_t)ug * 4096 + (16 * rt + l16) * 64 + 32 * ks + 8 * q4);
    float rr[8][4];
#pragma unroll
    for (int w = 0; w < 8; ++w)
#pragma unroll
        for (int r = 0; r < 4; ++r) rr[w][r] = bf2f(Z[(row0 + 16 * rt + 4 * q4 + r) * NZ_AB + 2560 + h * 128 + 16 * w + l16]);
#pragma unroll
    for (int w = 0; w < 8; ++w)
#pragma unroll
        for (int ks = 0; ks < 2; ++ks) { const bf16x8 B2 = *(const bf16x8*)(W.SPT + (size_t)ug * 8192 + (16 * w + l16) * 64 + 32 * ks + 8 * q4); o[w] = MFMA16(A2[ks], B2, o[w]); }
    float rstd[4];
#pragma unroll
    for (int r = 0; r < 4; ++r) { float ss = 0.f;
#pragma unroll
        for (int w = 0; w < 8; ++w) ss += o[w][r] * o[w][r];
        ss += __shfl_xor(ss, 1); ss += __shfl_xor(ss, 2); ss += __shfl_xor(ss, 4); ss += __shfl_xor(ss, 8);
        rstd[r] = rsqrtf(ss * (1.f / 128.f) + EPS); }
#pragma unroll
    for (int w = 0; w < 8; ++w) { const float gg = ggla[h * 128 + 16 * w + l16];
#pragma unroll
        for (int r = 0; r < 4; ++r) { const float rv = rr[w][r];
            CAT[(row0 + 16 * rt + 4 * q4 + r) * DM + 512 + h * 128 + 16 * w + l16] = f2bf(o[w][r] * rstd[r] * gg * rv * __builtin_amdgcn_rcpf(1.f + __expf(-rv))); } }
}

#define XB_TMO      128
#define XB_XCNT(j)  (256  + 64 * (j))
#define XB_XSUB(j)  (1280 + 64 * (j))
#define XB_XGEN(j)  (2304 + 64 * (j))
#define XB_TOP      3328
#define XB_TOPGEN   3392
#define XCD_BAR_WORDS 3456
#define XB_SPIN_CAP (1u << 22)
__device__ __forceinline__ unsigned xb_ld(unsigned* p)              { return __hip_atomic_load(p, __ATOMIC_RELAXED, __HIP_MEMORY_SCOPE_AGENT); }
__device__ __forceinline__ unsigned xb_add(unsigned* p, unsigned v) { return __hip_atomic_fetch_add(p, v, __ATOMIC_RELAXED, __HIP_MEMORY_SCOPE_AGENT); }
__device__ __forceinline__ unsigned xb_xcc_id() { return (unsigned)__builtin_amdgcn_s_getreg((3 << 11) | 20) & 0xFu; }
#define XB_SPIN(cond, bar) do { unsigned _sp = 0; while (cond) { __builtin_amdgcn_s_sleep(1); \
    if ((++_sp & 255u) == 0u) { if (xb_ld(&(bar)[XB_TMO])) break; if (_sp > XB_SPIN_CAP) { atomicAdd(&(bar)[XB_TMO], 1u); break; } } } } while (0)
struct XcdBarrier { unsigned* bar; unsigned x; volatile LAS unsigned* st; };
__device__ __forceinline__ XcdBarrier xcd_barrier_post(unsigned* bar, volatile LAS unsigned* st) {
    XcdBarrier b; b.bar = bar; b.x = xb_xcc_id(); b.st = st;
    if (opaque_tid() == 0) (void)xb_add(&bar[XB_XCNT(b.x)], 1u);
    return b;
}
__device__ __forceinline__ void xcd_barrier_complete(unsigned* bar, unsigned x, unsigned& nloc, unsigned& nx) {
    const unsigned G = gridDim.x * gridDim.y * gridDim.z;
    unsigned sum, cnt, mine, sp = 0u;
    for (;;) {
        sum = 0u; cnt = 0u; mine = 0u;
#pragma unroll
        for (unsigned j = 0; j < 16; ++j) { const unsigned c = xb_ld(&bar[XB_XCNT(j)]); sum += c; cnt += (c > 0u) ? 1u : 0u; mine = (j == x) ? c : mine; }
        if (sum == G) break;
        __builtin_amdgcn_s_sleep(1);
        if ((++sp & 255u) == 0u) { if (xb_ld(&bar[XB_TMO])) break; if (sp > XB_SPIN_CAP) { atomicAdd(&bar[XB_TMO], 1u); break; } }
    }
    nloc = mine > 0u ? mine : 1u; nx = cnt > 0u ? cnt : 1u;
}
__device__ __forceinline__ void xcd_barrier(const XcdBarrier& b) {
    asm volatile("s_waitcnt vmcnt(0)" ::: "memory");
    __syncthreads();
    if (opaque_tid() == 0) {
        unsigned* bar = b.bar;
        __builtin_amdgcn_s_waitcnt(0);
        unsigned nloc = b.st[0], nx = b.st[1];
        if (nloc == 0u) { xcd_barrier_complete(bar, b.x, nloc, nx); b.st[0] = nloc; b.st[1] = nx; }
        const unsigned old = xb_add(&bar[XB_XSUB(b.x)], 1u);
        const unsigned gen = old / nloc;
        if (old + 1u == (gen + 1u) * nloc) {
            __builtin_amdgcn_fence(__ATOMIC_RELEASE, "agent");
            asm volatile("s_waitcnt vmcnt(0)" ::: "memory");
            const unsigned og = xb_add(&bar[XB_TOP], 1u);
            const unsigned tg = og / nx;
            if (og + 1u == (tg + 1u) * nx) xb_add(&bar[XB_TOPGEN], 1u);
            else XB_SPIN(xb_ld(&bar[XB_TOPGEN]) == tg, bar);
            __builtin_amdgcn_fence(__ATOMIC_ACQUIRE, "agent");
            xb_add(&bar[XB_XGEN(b.x)], 1u);
            asm volatile("s_waitcnt vmcnt(0)" ::: "memory");
        } else {
            XB_SPIN(xb_ld(&bar[XB_XGEN(b.x)]) == gen, bar);
            __builtin_amdgcn_fence(__ATOMIC_ACQUIRE, "agent");
            asm volatile("s_waitcnt vmcnt(0)" ::: "memory");
        }
    }
    __syncthreads();
}

constexpr int LDS_SLOT = 131072;
constexpr int LDS_BIAS = 131072 + 256;
__device__ __forceinline__ int next_unit(unsigned* ctr, LAS int* slot) {
    __syncthreads();
    if (opaque_tid() == 0) *slot = (int)atomicAdd(ctr, 1u);
    __syncthreads();
    return *slot;
}

__global__ void __launch_bounds__(512, 2) fwd_megakernel(Args a_unused) {
    extern __shared__ __attribute__((aligned(16))) unsigned char lds_raw[];
    LAS unsigned char* lds = (LAS unsigned char*)lds_raw;
    cg::grid_group grid = cg::this_grid();
    const int tid = opaque_tid(), lane = tid & 63, wave = __builtin_amdgcn_readfirstlane(tid >> 6);
    const int G = gridDim.x, gw = blockIdx.x * 8 + wave, NGW = G * 8;
#define PHASE_ARGS() const CAS4 Args& a = fresh_args(); unsigned char* ws = a.ws; unsigned* ctr = (unsigned*)(ws + WS_CTL); float* X = (float*)(ws + WS_X); bf16_t* H = (bf16_t*)(ws + WS_H); \
    bf16_t* Z = (bf16_t*)(ws + WS_Z); bf16_t* Gh = (bf16_t*)(ws + WS_Z); bf16_t* CAT = (bf16_t*)(ws + WS_CAT); bf16_t* VT = (bf16_t*)(ws + WS_VT); \
    (void)ctr; (void)X; (void)H; (void)Z; (void)Gh; (void)CAT; (void)VT
    LAS int* slot = (LAS int*)(lds + LDS_SLOT);
    LAS float* sbias = (LAS float*)(lds + LDS_BIAS);

    unsigned* barw;
    volatile LAS unsigned* bst = (volatile LAS unsigned*)(lds + LDS_SLOT + 16);
    {
    PHASE_ARGS();
    barw = ctr + 8192;
    if (tid < 2) bst[tid] = 0u;
    if (blockIdx.x == 0) { if (tid < 64) ctr[tid * 64] = 0u; for (int i = tid; i < XCD_BAR_WORDS; i += 512) barw[i] = 0u; }
    prologue_weights(a, lds, gw, NGW, wave, lane);
    norm_phase(a.in[I_XP], a.in[I_XS], X, a.in[I_GMIX], H, nullptr, 0, true, gw, NGW, lane);
    }
    grid.sync();
    const XcdBarrier xbar = xcd_barrier_post(barw, bst);
#define GRID_BAR() xcd_barrier(xbar)

#pragma nounroll
    for (int layer = 0; layer < 4; ++layer) {
        const int li = layer >> 1;
        if (layer > 0) { PHASE_ARGS(); norm_phase(nullptr, nullptr, X, a.in[I_GMIX] + layer * DM, H, (const float*)(ws + WS_PART), 11, false, gw, NGW, lane); GRID_BAR(); }
        if ((layer & 1) == 0) {
            {
                PHASE_ARGS();
                pg8::Gemm g{H, (const bf16_t*)(ws + WS_WIN + li * SZ_WIN), MP, NZ_AB, DM}; pg8::StaticOrder S; S.init(MPROMPT, NZ_AB, DM, 1, G, (int)blockIdx.x);
                EpiInAB E{Z, VT, a.out + O_AKP + (size_t)li * MPROMPT * 512, a.out + O_AVP + (size_t)li * MPROMPT * 512, a.out + O_AKS + (size_t)li * MSAMP * 512, a.out + O_AVS + (size_t)li * MSAMP * 512};
                pg8::gemm_phase<EpiInAB>(lds, g, S, E);
            }
            GRID_BAR();
            for (int rep = 0; rep <= REP_MIX_AB; ++rep) {
                PHASE_ARGS();
                const int shard = (int)blockIdx.x & 7;
                unsigned* c = ctr + 64 * (layer * 8 + shard); (void)rep;
                const float* wgate = a.in[I_WGATE] + (size_t)li * 16 * 256; const float* bgate = a.in[I_BGATE] + li * 256; const float* ggla = a.in[I_GGLA] + li * 512;
                const GlaWs W{(float*)(ws + WS_H), (float*)(ws + WS_GLA_UTS), (float*)(ws + WS_GLA_OI), (bf16_t*)(ws + WS_GLA_SPT), (bf16_t*)(ws + WS_GLA_QG), (float*)(ws + WS_GLA_D)};
                { int par = 0; for (int ug = blockIdx.x; ug < 1056; ug += G, par ^= 1) gla_stage1(Z, VT, wgate, bgate, W, ug, par, lds); }
                for (;;) {
                    const int tk = next_unit(c, slot);
                    if (tk >= 68) break;
                    const int u = tk < 4 ? tk * 8 + shard : 32;
                    if (u < 32) { const int it = u * 8 + wave, bh = it >> 2, b = bh >> 3, h = bh & 7, t0 = (it & 3) * 4;
                        const size_t cb = ((size_t)(li * NB + b) * PAST) * 512 + h * 64;
                        sample_attn_item<0, 4>(a.in[I_CAK] + cb, a.in[I_CAV] + cb, 512, PAST, t0, Z + (size_t)(MPROMPT + b * TSAMP) * NZ_AB, NZ_AB, h * 64, 512 + h * 64, 1024 + h * 64,
                                            CAT + (size_t)(MPROMPT + b * TSAMP) * DM + h * 64, sbias, (LAS float*)(lds + wave * 16384), (LAS float*)(lds + wave * 16384 + 4096), lane);
                    } else { const int v = tk - 4, qb = 7 - (v >> 3), bh = (v & 7) * 8 + shard;
                        sb_prompt_unit(Z, VT, CAT, lds, bh >> 3, bh & 7, qb, wave);
                    }
                }
                GRID_BAR();
                gla_scan(W, a.in[I_SB] + (size_t)li * 32 * 8192, a.out + O_BSP + (size_t)li * 32 * 8192, a.out + O_BSS + (size_t)li * 32 * 8192, (int)blockIdx.x * 512 + opaque_tid(), G * 512);
                GRID_BAR();
                for (int it = gw; it < 1056 * 4; it += NGW) gla_stage3_item(Z, CAT, ggla, W, it >> 2, it & 3);
                if (rep < REP_MIX_AB) GRID_BAR();
            }
            GRID_BAR();
            {
                PHASE_ARGS();
                pg8::Gemm g{CAT, (const bf16_t*)(ws + WS_WOAB + li * SZ_WO), MP, DM, DM}; pg8::StaticOrder S; S.init(MPROMPT, DM, DM, 4, G, (int)blockIdx.x);
                EpiResid E{X, (float*)(ws + WS_PART)}; pg8::gemm_phase<EpiResid>(lds, g, S, E);
            }
            GRID_BAR();
        } else {
            {
                PHASE_ARGS();
                pg8::Gemm g{H, (const bf16_t*)(ws + WS_WQKV + li * SZ_WQKV), MP, NZ_C, DM}; pg8::StaticOrder S; S.init(MPROMPT, NZ_C, DM, 1, G, (int)blockIdx.x);
                EpiInC E{Z, VT, a.out + O_CKP + (size_t)li * NB * CWIN * 1024, a.out + O_CVP + (size_t)li * NB * CWIN * 1024, a.out + O_CKS + (size_t)li * MSAMP * 1024, a.out + O_CVS + (size_t)li * MSAMP * 1024};
                pg8::gemm_phase<EpiInC>(lds, g, S, E);
            }
            GRID_BAR();
            for (int rep = 0; rep <= REP_MIX_C; ++rep) {
                PHASE_ARGS();
                const int shard = (int)blockIdx.x & 7;
                unsigned* c = ctr + 64 * (layer * 8 + shard); (void)rep;
                const float* rel = a.in[I_REL] + (size_t)li * 16 * 192;
                for (;;) {
                    const int tk = next_unit(c, slot);
                    if (tk >= 136) break;
                    const int u = tk < 8 ? tk * 8 + shard : 64;
                    if (u >= 64) { const int v = tk - 8;
                        const int qb = v < 96 ? 2 + v % 6 : (v < 112 ? 1 : 0), bh = (v < 96 ? v / 6 : (v < 112 ? v - 96 : v - 112)) * 8 + shard, b = bh >> 4, h = bh & 15;
                        { const int t2 = opaque_tid(); for (int i = t2; i < 768; i += 512) sbias[i] = rel[h * 192 + (i < 191 ? i : 191)] * 1.44269504f; }
                        __syncthreads();
                        band_prompt_unit(Z, VT, CAT, sbias, lds, b, h, qb, wave);
                    } else { const int it = u * 8 + wave, bh = it >> 2, b = bh >> 4, h = bh & 15, t0 = (it & 3) * 4;
                        LAS float* wbias = (LAS float*)(lds + wave * 16384 + 12288);
                        { const int l2 = opaque_tid() & 63; for (int i = l2; i < 192; i += 64) wbias[i] = rel[h * 192 + i]; }
                        LDS_WAIT();
                        const size_t cb = ((size_t)(li * NB + b) * CWIN) * 1024 + h * 64;
                        sample_attn_item<1, 4>(a.in[I_CCK] + cb, a.in[I_CCV] + cb, 1024, CWIN, t0, Z + (size_t)(MPROMPT + b * TSAMP) * NZ_C, NZ_C, h * 64, 1024 + h * 64, 2048 + h * 64,
                                            CAT + (size_t)(MPROMPT + b * TSAMP) * DM + h * 64, wbias, (LAS float*)(lds + wave * 16384), (LAS float*)(lds + wave * 16384 + 4096), lane);
                    }
                }
                if (rep < REP_MIX_C) GRID_BAR();
            }
            GRID_BAR();
            {
                PHASE_ARGS();
                pg8::Gemm g{CAT, (const bf16_t*)(ws + WS_WOC + li * SZ_WO), MP, DM, DM}; pg8::StaticOrder S; S.init(MPROMPT, DM, DM, 4, G, (int)blockIdx.x);
                EpiResid E{X, (float*)(ws + WS_PART)}; pg8::gemm_phase<EpiResid>(lds, g, S, E);
            }
            GRID_BAR();
        }
        { PHASE_ARGS(); norm_phase(nullptr, nullptr, X, a.in[I_GFFN] + layer * DM, H, (const float*)(ws + WS_PART), 4, false, gw, NGW, lane); }
        GRID_BAR();
        {
            PHASE_ARGS();
            pg8::Gemm g{H, (const bf16_t*)(ws + WS_WGU + layer * SZ_WGU), MP, NGU, DM}; pg8::StaticOrder S; S.init(MPROMPT, NGU, DM, 1, G, (int)blockIdx.x);
            EpiSwiglu E{Gh};
            for (int rep = 0; rep <= REP_UP; ++rep) { pg8::gemm_phase<EpiSwiglu>(lds, g, S, E); if (rep < REP_UP) GRID_BAR(); }
        }
        GRID_BAR();
        {
            PHASE_ARGS();
            pg8::Gemm g{Gh, (const bf16_t*)(ws + WS_WD + layer * SZ_WD), MP, DM, DFF}; pg8::StaticOrder S; S.init(MPROMPT, DM, DFF, 11, G, (int)blockIdx.x);
            EpiResid E{X, (float*)(ws + WS_PART)}; pg8::gemm_phase<EpiResid>(lds, g, S, E);
        }
        GRID_BAR();
    }
    { PHASE_ARGS(); final_norm_phase(X, a.in[I_GFIN], a.out + O_YP, (const float*)(ws + WS_PART), 11, gw, NGW, lane); }
}

extern "C" void kernel_launch(void* const* d_in, const int* in_sizes, int n_in, void* d_out, int out_size, void* d_ws, size_t ws_size, hipStream_t stream) {
    static int grid = 0;
    if (grid == 0) {
        if (n_in != 21 || (size_t)out_size != O_END || ws_size < WS_END) { fprintf(stderr, "kernel_launch: unexpected shapes (n_in %d, out %d vs %zu, ws %zu vs %zu)\n", n_in, out_size, (size_t)O_END, ws_size, (size_t)WS_END); grid = -1; return; }
        int dev = 0, cus = 0, per_cu = 0;
        hipGetDevice(&dev); hipDeviceGetAttribute(&cus, hipDeviceAttributeMultiprocessorCount, dev);
        if (hipFuncSetAttribute((const void*)fwd_megakernel, hipFuncAttributeMaxDynamicSharedMemorySize, LDS_BYTES) != hipSuccess) { fprintf(stderr, "kernel_launch: hipFuncSetAttribute failed\n"); grid = -1; return; }
        if (hipOccupancyMaxActiveBlocksPerMultiprocessor(&per_cu, (const void*)fwd_megakernel, 512, LDS_BYTES) != hipSuccess || per_cu < 1) { fprintf(stderr, "kernel_launch: occupancy query says %d\n", per_cu); per_cu = 1; }
        (void)hipGetLastError();
        grid = cus * per_cu;
    }
    if (grid < 0) return;
    Args a{};
    for (int i = 0; i < 21; ++i) a.in[i] = (const float*)d_in[i];
    a.out = (float*)d_out; a.ws = (unsigned char*)d_ws;
    void* args[] = {&a};
    hipError_t e = hipLaunchCooperativeKernel((const void*)fwd_megakernel, dim3(grid), dim3(512), args, LDS_BYTES, stream);
    if (e != hipSuccess) fprintf(stderr, "cooperative launch failed: %s (grid %d)\n", hipGetErrorString(e), grid);
}
```

```cpp
#include <hip/hip_runtime.h>
#include <hip/hip_cooperative_groups.h>
#include <cstdio>
#include <cstdint>
namespace cg = cooperative_groups;

#define LAS __attribute__((address_space(3)))
typedef unsigned short bf16_t;
typedef short bf16x8 __attribute__((ext_vector_type(8)));
typedef float f32x4 __attribute__((ext_vector_type(4)));
typedef float f32x16 __attribute__((ext_vector_type(16)));
typedef unsigned u32x4 __attribute__((ext_vector_type(4)));
typedef unsigned u32x2 __attribute__((ext_vector_type(2)));

constexpr int DM = 1024, TP = 2048, NB = 8, MPROMPT = NB * TP, TSAMP = 16, MSAMP = NB * TSAMP, MREAL = MPROMPT + MSAMP, MP = 16640;
constexpr int PAST = 2048, CWIN = 512;
constexpr int NZ_AB = 3328, NZ_C = 3072, DFF = 2816, NGU = 2 * DFF, AB_IN = 3088;
constexpr float EPS = 1e-6f;
constexpr bool SB_EARLY_EXIT = true;
constexpr float SB_EXIT_THR = -104.0f;

constexpr size_t O_YP = 0, O_YS = O_YP + (size_t)MPROMPT * DM, O_AKP = O_YS + (size_t)MSAMP * DM, O_AVP = O_AKP + (size_t)2 * MPROMPT * 512,
                 O_AKS = O_AVP + (size_t)2 * MPROMPT * 512, O_AVS = O_AKS + (size_t)2 * MSAMP * 512, O_BSP = O_AVS + (size_t)2 * MSAMP * 512,
                 O_BSS = O_BSP + (size_t)2 * NB * 4 * 64 * 128, O_CKP = O_BSS + (size_t)2 * NB * 4 * 64 * 128, O_CVP = O_CKP + (size_t)2 * NB * CWIN * 1024,
                 O_CKS = O_CVP + (size_t)2 * NB * CWIN * 1024, O_CVS = O_CKS + (size_t)2 * MSAMP * 1024, O_END = O_CVS + (size_t)2 * MSAMP * 1024;

constexpr size_t al256(size_t x) { return (x + 255) & ~(size_t)255; }
constexpr size_t WS_CTL = 0, WS_WIN = 1u << 20;
constexpr size_t SZ_WIN = (size_t)NZ_AB * DM * 2, SZ_WO = (size_t)DM * DM * 2, SZ_WQKV = (size_t)NZ_C * DM * 2, SZ_WGU = (size_t)NGU * DM * 2, SZ_WD = (size_t)DM * DFF * 2;
constexpr size_t WS_WOAB = WS_WIN + 2 * SZ_WIN, WS_WQKV = WS_WOAB + 2 * SZ_WO, WS_WOC = WS_WQKV + 2 * SZ_WQKV, WS_WGU = WS_WOC + 2 * SZ_WO, WS_WD = WS_WGU + 4 * SZ_WGU;
constexpr size_t WS_X = al256(WS_WD + 4 * SZ_WD), WS_H = WS_X + (size_t)MP * DM * 4, WS_Z = WS_H + (size_t)MP * DM * 2, WS_CAT = WS_Z + (size_t)MP * NZ_AB * 2,
                 WS_VT = WS_CAT + (size_t)MP * DM * 2, WS_GLA_OI = WS_VT + (size_t)1024 * MP * 2, WS_GLA_SPT = WS_GLA_OI + (size_t)1056 * 32768,
                 WS_GLA_QG = WS_GLA_SPT + (size_t)1056 * 16384, WS_GLA_D = WS_GLA_QG + (size_t)1056 * 8192, WS_GLA_UTS = WS_GLA_D + (size_t)1056 * 256, WS_PART = WS_GLA_UTS + (size_t)32 * 32768, WS_END = WS_PART + (size_t)11 * MSAMP * DM * 4;
static_assert((size_t)1024 * 32768 <= (size_t)MP * DM * 2, "prompt U^T images overlay H");

#ifndef REP_MIX_AB
#define REP_MIX_AB 0
#endif
#ifndef REP_MIX_C
#define REP_MIX_C 0
#endif
#ifndef REP_UP
#define REP_UP 0
#endif
constexpr int LDS_BYTES = 147456;

__device__ __forceinline__ unsigned cvt_pk_bf16(float lo, float hi) { unsigned r; asm volatile("v_cvt_pk_bf16_f32 %0, %1, %2" : "=v"(r) : "v"(lo), "v"(hi)); return r; }
__device__ __forceinline__ bf16_t f2bf(float f) { return (bf16_t)(cvt_pk_bf16(f, 0.f) & 0xffffu); }
__device__ __forceinline__ float bf2f(bf16_t v) { return __uint_as_float((unsigned)v << 16); }
__device__ __forceinline__ float bflo(unsigned v) { return __uint_as_float(v << 16); }
__device__ __forceinline__ float bfhi(unsigned v) { return __uint_as_float(v & 0xffff0000u); }
__device__ __forceinline__ float wave_sum(float v) {
#pragma unroll
    for (int o = 1; o < 64; o <<= 1) v += __shfl_xor(v, o);
    return v;
}
__device__ __forceinline__ float wave_max(float v) {
#pragma unroll
    for (int o = 1; o < 64; o <<= 1) v = fmaxf(v, __shfl_xor(v, o));
    return v;
}
__device__ __forceinline__ float log_sigmoid_f(float z) { return fminf(z, 0.f) - 0.69314718f * __builtin_amdgcn_logf(1.f + __expf(-fabsf(z))); }
__device__ __forceinline__ int crow(int r, int hi) { return (r & 3) + 8 * (r >> 2) + 4 * hi; }
#define LDS_WAIT() asm volatile("s_waitcnt lgkmcnt(0)" ::: "memory")
__device__ __forceinline__ int opaque_tid() { int t = threadIdx.x; asm volatile("" : "+v"(t)); return t; }

namespace pg8 {
constexpr int BM = 256, BK = 64, HALF = 128, HTB = HALF * BK * 2, STAGE_BYTES = 8 * HTB, NXCD = 8, WGM = 8;
__host__ __device__ __forceinline__ int lds_byte(int r, int c) { const int st = (r >> 4) * 2 + (c >> 5), rr = r & 15, cc = c & 31, ob = rr * 64 + cc * 2; return st * 1024 + (ob ^ (((ob >> 9) & 1) << 5)); }
__host__ __device__ __forceinline__ void stage_rc(int b, int& R, int& C) { const int st = b / 1024, sb = b % 1024, swz = sb ^ (((sb >> 9) & 1) << 5); R = (st >> 1) * 16 + swz / 64; C = (st & 1) * 32 + (swz % 64) / 2; }
__host__ __device__ __forceinline__ int perm32(int rho) { const int n = rho >> 4, i = rho & 15; return 8 * (i >> 2) + 4 * n + (i & 3); }
struct Unit { int pm, pn, kt0, nkt, split; };
struct Gemm { const bf16_t* A; const bf16_t* Bt; int M, N, K; };
struct StaticOrder {
    int nM, nN, nmain, nwg, G, c, ktiles, nsplit;
    __host__ __device__ void init(int Mmain, int N, int K, int nsplit_, int G_, int c_) { nM = Mmain / BM; nN = N / BM; nmain = nM * nN; ktiles = K / BK; nsplit = nsplit_; nwg = nmain + nN * nsplit; G = G_; c = c_; }
    __host__ __device__ bool next(int i, Unit& u) const {
        const long L = (long)i * G + c; if (L >= nwg) return false;
        if (L < nmain) {
            int wgid = (int)L; { const int q = nmain / NXCD, r = nmain % NXCD, xcd = wgid % NXCD, off = wgid / NXCD; wgid = (xcd < r ? xcd * (q + 1) : r * (q + 1) + (xcd - r) * q) + off; }
            const int nig = WGM * nN, gid = wgid / nig, fm = gid * WGM, gsz = (nM - fm) < WGM ? (nM - fm) : WGM;
            u.pm = fm + ((wgid % nig) % gsz); u.pn = (wgid % nig) / gsz; u.kt0 = 0; u.nkt = ktiles; u.split = 0;
        } else {
            const int s2 = (int)L - nmain; u.pm = nM; u.pn = s2 % nN; u.nkt = ktiles / nsplit; u.kt0 = (s2 / nN) * u.nkt; u.split = nsplit > 1 ? 1 : 0;
        }
        return true;
    }
};
template <class Epi>
__device__ __forceinline__ void gemm_phase(LAS unsigned char* lds, const Gemm g, const StaticOrder& S, const Epi& E) {
    const int tid = opaque_tid(), wid = __builtin_amdgcn_readfirstlane(tid >> 6), lane = tid & 63, wr = wid >> 2, wc = wid & 3, fr = lane & 15, fq = lane >> 4;
    const int K = g.K;
    unsigned voffA[2], voffB[2];
#pragma unroll
    for (int i = 0; i < 2; ++i) { int R, C; stage_rc(tid * 16 + i * 8192, R, C); const int Rb = Epi::PERM ? ((R & ~31) + perm32(R & 31)) : R;
        voffA[i] = (unsigned)(R * K + C) * 2u; voffB[i] = (unsigned)(Rb * K + C) * 2u; }
    const size_t kstep = (size_t)(BK * 2);
    const size_t hstep = (size_t)HALF * K * 2;
    const size_t tstep = 2 * hstep;
    const unsigned ldsw = (unsigned)wid * 1024u;
    const int aoff = lds_byte(wr * 64 + fr, fq * 8), boff = lds_byte(wc * 32 + fr, fq * 8);
#define PG8_SA(b, h) (((b) * 2 + (h)) * HTB)
#define PG8_SB(b, h) ((4 + (b) * 2 + (h)) * HTB)
#define PG8_STAGE(bufoff, gbase, voff) do { _Pragma("unroll") for (int _i = 0; _i < 2; ++_i) \
        __builtin_amdgcn_global_load_lds((const unsigned*)((const char*)(gbase) + (voff)[_i]), (LAS unsigned*)(lds + (bufoff) + ldsw + _i * 8192), 16, 0, 0); } while (0)
#define PG8_LDA(dst, b, h) do { _Pragma("unroll") for (int m = 0; m < 4; ++m) _Pragma("unroll") for (int k = 0; k < 2; ++k) dst[m][k] = *(const LAS bf16x8*)(lds + PG8_SA(b, h) + aoff + m * 2048 + k * 1024); } while (0)
#define PG8_LDB(dst, b, h) do { _Pragma("unroll") for (int n = 0; n < 2; ++n) _Pragma("unroll") for (int k = 0; k < 2; ++k) dst[n][k] = *(const LAS bf16x8*)(lds + PG8_SB(b, h) + boff + n * 2048 + k * 1024); } while (0)
#define PG8_MMA(ai, bj, At, Bt) do { __builtin_amdgcn_s_setprio(1); _Pragma("unroll") for (int m = 0; m < 4; ++m) _Pragma("unroll") for (int n = 0; n < 2; ++n) _Pragma("unroll") for (int k = 0; k < 2; ++k) \
        acc[ai][bj][m][n] = __builtin_amdgcn_mfma_f32_16x16x32_bf16(Bt[n][k], At[m][k], acc[ai][bj][m][n], 0, 0, 0); __builtin_amdgcn_s_setprio(0); } while (0)
#define PG8_WAIT_V(n) asm volatile("s_waitcnt vmcnt(" #n ")" ::: "memory")
#define PG8_WAIT_L(n) asm volatile("s_waitcnt lgkmcnt(" #n ")" ::: "memory")
#define PG8_BAR __builtin_amdgcn_s_barrier()
#define PG8_SCHED __builtin_amdgcn_sched_barrier(0)
    Unit cur, nxt; int ui = 0;
    if (!S.next(0, cur)) return;
    f32x4 acc[2][2][4][2];
    if constexpr (Epi::HAS_INIT) E.init(acc, cur, wr, wc, fr, fq);
    else {
#pragma unroll
    for (int a = 0; a < 2; ++a)
#pragma unroll
        for (int b = 0; b < 2; ++b)
#pragma unroll
            for (int m = 0; m < 4; ++m)
#pragma unroll
                for (int n = 0; n < 2; ++n) acc[a][b][m][n] = (f32x4){0.f, 0.f, 0.f, 0.f};
    }
    bf16x8 At[4][2], B0[2][2], B1[2][2];
    const char* cA = (const char*)g.A + (size_t)cur.pm * tstep + (size_t)cur.kt0 * kstep; const char* cB = (const char*)g.Bt + (size_t)cur.pn * tstep + (size_t)cur.kt0 * kstep;
    PG8_STAGE(PG8_SB(0, 0), cB, voffB); PG8_STAGE(PG8_SB(0, 1), cB + hstep, voffB); PG8_STAGE(PG8_SA(0, 0), cA, voffA); PG8_STAGE(PG8_SA(0, 1), cA + hstep, voffA);
    if (wr == 1) PG8_BAR;
    PG8_WAIT_V(2); PG8_BAR;
    PG8_STAGE(PG8_SB(1, 0), cB + kstep, voffB); PG8_STAGE(PG8_SA(1, 0), cA + kstep, voffA); PG8_STAGE(PG8_SB(1, 1), cB + hstep + kstep, voffB);
    PG8_WAIT_V(6); PG8_BAR;
    for (;;) {
        const bool has_next = S.next(ui + 1, nxt);
        const char* nA = has_next ? (const char*)g.A + (size_t)nxt.pm * tstep + (size_t)nxt.kt0 * kstep : cA; const char* nB = has_next ? (const char*)g.Bt + (size_t)nxt.pn * tstep + (size_t)nxt.kt0 * kstep : cB;
        const int nt = cur.nkt;
        for (int t = 0; t < nt; t += 2) {
            const bool last = (t == nt - 2);
            const char* a1 = cA + (size_t)(t + 1) * kstep;
            const char* a2 = last ? nA : cA + (size_t)(t + 2) * kstep; const char* b2 = last ? nB : cB + (size_t)(t + 2) * kstep;
            const char* a3 = a2 + kstep; const char* b3 = b2 + kstep;
            PG8_LDB(B0, 0, 0); PG8_LDB(B1, 0, 1); PG8_SCHED; PG8_LDA(At, 0, 0); PG8_STAGE(PG8_SA(1, 1), a1 + hstep, voffA);
            PG8_WAIT_V(8); PG8_WAIT_L(0); PG8_BAR; PG8_MMA(0, 0, At, B0); PG8_MMA(0, 1, At, B1); PG8_BAR; PG8_SCHED;
            PG8_LDA(At, 0, 1); PG8_STAGE(PG8_SB(0, 0), b2, voffB); PG8_STAGE(PG8_SB(0, 1), b2 + hstep, voffB); PG8_STAGE(PG8_SA(0, 0), a2, voffA);
            PG8_WAIT_V(8); PG8_WAIT_L(0); PG8_BAR; PG8_MMA(1, 0, At, B0); PG8_MMA(1, 1, At, B1); PG8_BAR; PG8_SCHED;
            PG8_LDB(B0, 1, 0); PG8_LDB(B1, 1, 1); PG8_SCHED; PG8_LDA(At, 1, 0); PG8_STAGE(PG8_SA(0, 1), a2 + hstep, voffA);
            PG8_WAIT_V(8); PG8_WAIT_L(0); PG8_BAR; PG8_MMA(0, 0, At, B0); PG8_MMA(0, 1, At, B1); PG8_BAR; PG8_SCHED;
            PG8_LDA(At, 1, 1); PG8_STAGE(PG8_SB(1, 0), b3, voffB); PG8_STAGE(PG8_SB(1, 1), b3 + hstep, voffB); PG8_STAGE(PG8_SA(1, 0), a3, voffA);
            PG8_WAIT_V(8); PG8_WAIT_L(0); PG8_BAR; PG8_MMA(1, 0, At, B0); PG8_MMA(1, 1, At, B1); PG8_BAR; PG8_SCHED;
        }
        if (wr == 0) PG8_BAR;
        E(acc, cur, wr, wc, fr, fq);
        if (!has_next) break;
        if constexpr (Epi::HAS_INIT) E.init(acc, nxt, wr, wc, fr, fq);
        else {
#pragma unroll
        for (int a = 0; a < 2; ++a)
#pragma unroll
            for (int b = 0; b < 2; ++b)
#pragma unroll
                for (int m = 0; m < 4; ++m)
#pragma unroll
                    for (int n = 0; n < 2; ++n) acc[a][b][m][n] = (f32x4){0.f, 0.f, 0.f, 0.f};
        }
        cur = nxt; cA = nA; cB = nB; ++ui;
        if (wr == 1) PG8_BAR;
    }
    PG8_WAIT_V(0);
    PG8_BAR;
#undef PG8_SA
#undef PG8_SB
#undef PG8_STAGE
#undef PG8_LDA
#undef PG8_LDB
#undef PG8_MMA
#undef PG8_WAIT_V
#undef PG8_WAIT_L
#undef PG8_BAR
#undef PG8_SCHED
}
}

struct EpiInAB {
    static constexpr bool PERM = true, HAS_INIT = false;
    bf16_t* Z; bf16_t* VT; float* akp; float* avp; float* aks; float* avs;
    __device__ __forceinline__ void operator()(const f32x4 (&acc)[2][2][4][2], const pg8::Unit& u, int wr, int wc, int fr, int fq) const {
        const int pn = u.pn, colb = pn * 256 + wc * 32 + 8 * fq;
        const bool isk = (pn == 2 || pn == 3), isv = (pn == 4 || pn == 5), isvb = (pn == 8 || pn == 9);
#pragma unroll
        for (int ai = 0; ai < 2; ++ai)
#pragma unroll
            for (int m = 0; m < 4; ++m) {
                const int row = u.pm * 256 + ai * 128 + wr * 64 + m * 16 + fr;
#pragma unroll
                for (int bj = 0; bj < 2; ++bj) {
                    const int c = colb + bj * 128; const f32x4 v0 = acc[ai][bj][m][0], v1 = acc[ai][bj][m][1];
                    u32x4 w; w.x = cvt_pk_bf16(v0[0], v0[1]); w.y = cvt_pk_bf16(v0[2], v0[3]); w.z = cvt_pk_bf16(v1[0], v1[1]); w.w = cvt_pk_bf16(v1[2], v1[3]);
                    *(u32x4*)(Z + (size_t)row * NZ_AB + c) = w;
                    if (isk || isv) {
                        const int cc = c - (isk ? 512 : 1024);
                        float* dst = nullptr;
                        if (row < MPROMPT) dst = (isk ? akp : avp) + (size_t)row * 512 + cc;
                        else if (row < MREAL) dst = (isk ? aks : avs) + (size_t)(row - MPROMPT) * 512 + cc;
                        if (dst) { __builtin_nontemporal_store(v0, (f32x4*)dst); __builtin_nontemporal_store(v1, (f32x4*)(dst + 4)); }
                    }
                    if (isv || isvb) {
                        const int vc = isv ? (c - 1024) : (512 + c - 2048);
                        bf16_t* p = VT + (size_t)vc * MP + row;
                        p[0] = (bf16_t)(w.x & 0xffffu); p[(size_t)MP] = (bf16_t)(w.x >> 16); p[(size_t)2 * MP] = (bf16_t)(w.y & 0xffffu); p[(size_t)3 * MP] = (bf16_t)(w.y >> 16);
                        p[(size_t)4 * MP] = (bf16_t)(w.z & 0xffffu); p[(size_t)5 * MP] = (bf16_t)(w.z >> 16); p[(size_t)6 * MP] = (bf16_t)(w.w & 0xffffu); p[(size_t)7 * MP] = (bf16_t)(w.w >> 16);
                    }
                }
            }
    }
};
struct EpiInC {
    static constexpr bool PERM = true, HAS_INIT = false;
    bf16_t* Z; bf16_t* VT; float* ckp; float* cvp; float* cks; float* cvs;
    __device__ __forceinline__ void operator()(const f32x4 (&acc)[2][2][4][2], const pg8::Unit& u, int wr, int wc, int fr, int fq) const {
        const int pn = u.pn, colb = pn * 256 + wc * 32 + 8 * fq;
        const bool isk = (pn >= 4 && pn < 8), isv = (pn >= 8);
#pragma unroll
        for (int ai = 0; ai < 2; ++ai)
#pragma unroll
            for (int m = 0; m < 4; ++m) {
                const int row = u.pm * 256 + ai * 128 + wr * 64 + m * 16 + fr;
#pragma unroll
                for (int bj = 0; bj < 2; ++bj) {
                    const int c = colb + bj * 128; const f32x4 v0 = acc[ai][bj][m][0], v1 = acc[ai][bj][m][1];
                    u32x4 w; w.x = cvt_pk_bf16(v0[0], v0[1]); w.y = cvt_pk_bf16(v0[2], v0[3]); w.z = cvt_pk_bf16(v1[0], v1[1]); w.w = cvt_pk_bf16(v1[2], v1[3]);
                    *(u32x4*)(Z + (size_t)row * NZ_C + c) = w;
                    if (isk || isv) {
                        const int cc = c - (isk ? 1024 : 2048);
                        float* dst = nullptr;
                        if (row < MPROMPT) { const int t = row & (TP - 1), b = row >> 11; if (t >= TP - CWIN) dst = (isk ? ckp : cvp) + ((size_t)b * CWIN + (t - (TP - CWIN))) * 1024 + cc; }
                        else if (row < MREAL) dst = (isk ? cks : cvs) + (size_t)(row - MPROMPT) * 1024 + cc;
                        if (dst) { __builtin_nontemporal_store(v0, (f32x4*)dst); __builtin_nontemporal_store(v1, (f32x4*)(dst + 4)); }
                    }
                    if (isv) {
                        const int vc = c - 2048;
                        bf16_t* p = VT + (size_t)vc * MP + row;
                        p[0] = (bf16_t)(w.x & 0xffffu); p[(size_t)MP] = (bf16_t)(w.x >> 16); p[(size_t)2 * MP] = (bf16_t)(w.y & 0xffffu); p[(size_t)3 * MP] = (bf16_t)(w.y >> 16);
                        p[(size_t)4 * MP] = (bf16_t)(w.z & 0xffffu); p[(size_t)5 * MP] = (bf16_t)(w.z >> 16); p[(size_t)6 * MP] = (bf16_t)(w.w & 0xffffu); p[(size_t)7 * MP] = (bf16_t)(w.w >> 16);
                    }
                }
            }
    }
};
struct EpiResid {
    static constexpr bool PERM = false, HAS_INIT = true;
    float* X; float* P;
    __device__ __forceinline__ void init(f32x4 (&acc)[2][2][4][2], const pg8::Unit& u, int wr, int wc, int fr, int fq) const {
        const int col0 = u.pn * 256 + wc * 32 + 4 * fq;
        if (u.split) {
#pragma unroll
            for (int ai = 0; ai < 2; ++ai)
#pragma unroll
                for (int bj = 0; bj < 2; ++bj)
#pragma unroll
                    for (int m = 0; m < 4; ++m)
#pragma unroll
                        for (int n = 0; n < 2; ++n) acc[ai][bj][m][n] = (f32x4){0.f, 0.f, 0.f, 0.f};
            return;
        }
#pragma unroll
        for (int ai = 0; ai < 2; ++ai)
#pragma unroll
            for (int m = 0; m < 4; ++m) {
                const float* rp = X + (size_t)(u.pm * 256 + ai * 128 + wr * 64 + m * 16 + fr) * DM + col0;
#pragma unroll
                for (int bj = 0; bj < 2; ++bj)
#pragma unroll
                    for (int n = 0; n < 2; ++n) acc[ai][bj][m][n] = __builtin_nontemporal_load((const f32x4*)(rp + bj * 128 + n * 16));
            }
    }
    __device__ __forceinline__ void operator()(const f32x4 (&acc)[2][2][4][2], const pg8::Unit& u, int wr, int wc, int fr, int fq) const {
        const int col0 = u.pn * 256 + wc * 32 + 4 * fq;
        if (u.split) {
            float* pb = P + (size_t)(u.kt0 / u.nkt) * MSAMP * DM;
#pragma unroll
            for (int m = 0; m < 4; ++m) {
                float* rp = pb + (size_t)(wr * 64 + m * 16 + fr) * DM + col0;
#pragma unroll
                for (int bj = 0; bj < 2; ++bj)
#pragma unroll
                    for (int n = 0; n < 2; ++n) *(f32x4*)(rp + bj * 128 + n * 16) = acc[0][bj][m][n];
            }
            return;
        }
#pragma unroll
        for (int ai = 0; ai < 2; ++ai)
#pragma unroll
            for (int m = 0; m < 4; ++m) {
                float* rp = X + (size_t)(u.pm * 256 + ai * 128 + wr * 64 + m * 16 + fr) * DM + col0;
#pragma unroll
                for (int bj = 0; bj < 2; ++bj)
#pragma unroll
                    for (int n = 0; n < 2; ++n) *(f32x4*)(rp + bj * 128 + n * 16) = acc[ai][bj][m][n];
            }
    }
};
struct EpiSwiglu {
    static constexpr bool PERM = true, HAS_INIT = false;
    bf16_t* G;
    __device__ __forceinline__ void operator()(const f32x4 (&acc)[2][2][4][2], const pg8::Unit& u, int wr, int wc, int fr, int fq) const {
        const int col0 = u.pn * 128 + wc * 32 + 8 * fq;
#pragma unroll
        for (int ai = 0; ai < 2; ++ai)
#pragma unroll
            for (int m = 0; m < 4; ++m) {
                const int row = u.pm * 256 + ai * 128 + wr * 64 + m * 16 + fr;
                float o[8];
#pragma unroll
                for (int n = 0; n < 2; ++n)
#pragma unroll
                    for (int j = 0; j < 4; ++j) { const float g = acc[ai][0][m][n][j], uu = acc[ai][1][m][n][j]; o[n * 4 + j] = g * __builtin_amdgcn_rcpf(1.f + __expf(-g)) * uu; }
                u32x4 w; w.x = cvt_pk_bf16(o[0], o[1]); w.y = cvt_pk_bf16(o[2], o[3]); w.z = cvt_pk_bf16(o[4], o[5]); w.w = cvt_pk_bf16(o[6], o[7]);
                *(u32x4*)(G + (size_t)row * DFF + col0) = w;
            }
    }
};

__device__ __forceinline__ void tr_item(const float* W, int K, int Nsrc, int c0, int nvalid, bf16_t* WT, int r0, int k0, LAS float* scr, int lane) {
    const int cc = lane & 31;
    float tv[32];
#pragma unroll
    for (int i = 0; i < 32; ++i) { const int kk = 2 * i + (lane >> 5); tv[i] = (cc < nvalid) ? __builtin_nontemporal_load(W + (size_t)(k0 + kk) * Nsrc + c0 + cc) : 0.f; }
#pragma unroll
    for (int i = 0; i < 32; ++i) { const int kk = 2 * i + (lane >> 5); scr[kk * 33 + cc] = tv[i]; }
    LDS_WAIT();
    const int c = lane & 7;
#pragma unroll
    for (int j = 0; j < 4; ++j) { const int n = (lane >> 3) + 8 * j; const LAS float* s = scr + (8 * c) * 33 + n;
        u32x4 o; o.x = cvt_pk_bf16(s[0 * 33], s[1 * 33]); o.y = cvt_pk_bf16(s[2 * 33], s[3 * 33]); o.z = cvt_pk_bf16(s[4 * 33], s[5 * 33]); o.w = cvt_pk_bf16(s[6 * 33], s[7 * 33]);
        *(u32x4*)(WT + (size_t)(r0 + n) * K + k0 + 8 * c) = o; }
    LDS_WAIT();
}

struct Args { const float* in[21]; float* out; unsigned char* ws; };
enum { I_XP = 0, I_XS, I_CAK, I_CAV, I_SB, I_CCK, I_CCV, I_GMIX, I_GFFN, I_WIN, I_WGATE, I_BGATE, I_GGLA, I_WOAB, I_WQKV, I_REL, I_WOC, I_WFG, I_WFU, I_WFD, I_GFIN };

#define CAS4 __attribute__((address_space(4)))
__device__ __forceinline__ const CAS4 Args& fresh_args() { const CAS4 Args* p = (const CAS4 Args*)__builtin_amdgcn_kernarg_segment_ptr(); asm volatile("" : "+s"(p)); return *p; }

__device__ __forceinline__ void prologue_weights(const CAS4 Args& a, LAS unsigned char* lds, int gw, int NGW, int wave, int lane) {
    lane = opaque_tid() & 63;
    LAS float* scr = (LAS float*)(lds + wave * 16384);
    unsigned char* ws = a.ws;
    constexpr int KB1 = DM / 64, KB2 = DFF / 64;
    constexpr int N_IN = 2 * (NZ_AB / 32) * KB1, N_OAB = 2 * 32 * KB1, N_QKV = 2 * (NZ_C / 32) * KB1, N_OC = 2 * 32 * KB1, N_GU = 4 * (NGU / 32) * KB1, N_D = 4 * 32 * KB2;
    constexpr int NITEMS = N_IN + N_OAB + N_QKV + N_OC + N_GU + N_D;
    for (int it = gw; it < NITEMS; it += NGW) {
        int r = it;
        if (r < N_IN) { const int per = (NZ_AB / 32) * KB1, L = r / per, q = r % per, db = q / KB1, kb = q % KB1;
            int c0, nv; if (db < 80) { c0 = 32 * db; nv = 32; } else if (db < 96) { c0 = 2576 + 32 * (db - 80); nv = 32; } else if (db == 96) { c0 = 2560; nv = 16; } else { c0 = 0; nv = 0; }
            tr_item(a.in[I_WIN] + (size_t)L * DM * AB_IN, DM, AB_IN, c0, nv, (bf16_t*)(ws + WS_WIN + L * SZ_WIN), 32 * db, 64 * kb, scr, lane); continue; } r -= N_IN;
        if (r < N_OAB) { const int per = 32 * KB1, L = r / per, q = r % per, db = q / KB1, kb = q % KB1;
            tr_item(a.in[I_WOAB] + (size_t)L * DM * DM, DM, DM, 32 * db, 32, (bf16_t*)(ws + WS_WOAB + L * SZ_WO), 32 * db, 64 * kb, scr, lane); continue; } r -= N_OAB;
        if (r < N_QKV) { const int per = (NZ_C / 32) * KB1, L = r / per, q = r % per, db = q / KB1, kb = q % KB1;
            tr_item(a.in[I_WQKV] + (size_t)L * DM * NZ_C, DM, NZ_C, 32 * db, 32, (bf16_t*)(ws + WS_WQKV + L * SZ_WQKV), 32 * db, 64 * kb, scr, lane); continue; } r -= N_QKV;
        if (r < N_OC) { const int per = 32 * KB1, L = r / per, q = r % per, db = q / KB1, kb = q % KB1;
            tr_item(a.in[I_WOC] + (size_t)L * DM * DM, DM, DM, 32 * db, 32, (bf16_t*)(ws + WS_WOC + L * SZ_WO), 32 * db, 64 * kb, scr, lane); continue; } r -= N_OC;
        if (r < N_GU) { const int per = (NGU / 32) * KB1, L = r / per, q = r % per, db = q / KB1, kb = q % KB1, tile = db >> 3, wi = db & 7;
            const float* src = (wi < 4 ? a.in[I_WFG] : a.in[I_WFU]) + (size_t)L * DM * DFF;
            tr_item(src, DM, DFF, 128 * tile + 32 * (wi & 3), 32, (bf16_t*)(ws + WS_WGU + L * SZ_WGU), 32 * db, 64 * kb, scr, lane); continue; } r -= N_GU;
        { const int per = 32 * KB2, L = r / per, q = r % per, db = q / KB2, kb = q % KB2;
            tr_item(a.in[I_WFD] + (size_t)L * DFF * DM, DFF, DM, 32 * db, 32, (bf16_t*)(ws + WS_WD + L * SZ_WD), 32 * db, 64 * kb, scr, lane); }
    }
}

__device__ __forceinline__ void norm_phase(const float* xp, const float* xs, float* X, const float* g, bf16_t* H, const float* P, int nsplit, bool first, int gw, int NGW, int lane) {
    lane = opaque_tid() & 63;
    f32x4 gv[4];
#pragma unroll
    for (int j = 0; j < 4; ++j) gv[j] = *((const f32x4*)g + lane + 64 * j);
    for (int row = gw; row < MP; row += NGW) {
        const float* src = X + (size_t)row * DM;
        if (first) src = row < MPROMPT ? xp + (size_t)row * DM : (row < MREAL ? xs + (size_t)(row - MPROMPT) * DM : nullptr);
        f32x4 v[4];
#pragma unroll
        for (int j = 0; j < 4; ++j) v[j] = src ? __builtin_nontemporal_load((const f32x4*)src + lane + 64 * j) : (f32x4){0.f, 0.f, 0.f, 0.f};
        const bool fold = !first && row >= MPROMPT && row < MREAL;
        if (fold) {
            for (int s2 = 0; s2 < nsplit; s2 += 4) { f32x4 t[4][4];
#pragma unroll
                for (int k = 0; k < 4; ++k) { const int sk = (s2 + k < nsplit) ? s2 + k : s2; const f32x4* pp = (const f32x4*)(P + ((size_t)sk * MSAMP + (row - MPROMPT)) * DM) + lane;
#pragma unroll
                    for (int j = 0; j < 4; ++j) t[k][j] = pp[64 * j]; }
#pragma unroll
                for (int k = 0; k < 4; ++k) if (s2 + k < nsplit) {
#pragma unroll
                    for (int j = 0; j < 4; ++j) v[j] = v[j] + t[k][j]; } }
        }
        float s = 0.f;
#pragma unroll
        for (int j = 0; j < 4; ++j) s += (v[j].x * v[j].x + v[j].y * v[j].y) + (v[j].z * v[j].z + v[j].w * v[j].w);
        const float rs = rsqrtf(wave_sum(s) * (1.f / DM) + EPS);
        u32x2* o = (u32x2*)(H + (size_t)row * DM) + lane;
#pragma unroll
        for (int j = 0; j < 4; ++j) { const f32x4 y = v[j] * rs * gv[j]; u32x2 w; w.x = cvt_pk_bf16(y.x, y.y); w.y = cvt_pk_bf16(y.z, y.w); o[64 * j] = w;
            if (first || fold) *((f32x4*)(X + (size_t)row * DM) + lane + 64 * j) = v[j]; }
    }
}
__device__ __forceinline__ void final_norm_phase(const float* X, const float* g, float* Y, const float* P, int nsplit, int gw, int NGW, int lane) {
    lane = opaque_tid() & 63;
    f32x4 gv[4];
#pragma unroll
    for (int j = 0; j < 4; ++j) gv[j] = *((const f32x4*)g + lane + 64 * j);
    for (int row = gw; row < MREAL; row += NGW) {
        const float* src = X + (size_t)row * DM;
        f32x4 v[4];
#pragma unroll
        for (int j = 0; j < 4; ++j) v[j] = __builtin_nontemporal_load((const f32x4*)src + lane + 64 * j);
        if (row >= MPROMPT) {
            for (int s2 = 0; s2 < nsplit; s2 += 4) { f32x4 t[4][4];
#pragma unroll
                for (int k = 0; k < 4; ++k) { const int sk = (s2 + k < nsplit) ? s2 + k : s2; const f32x4* pp = (const f32x4*)(P + ((size_t)sk * MSAMP + (row - MPROMPT)) * DM) + lane;
#pragma unroll
                    for (int j = 0; j < 4; ++j) t[k][j] = pp[64 * j]; }
#pragma unroll
                for (int k = 0; k < 4; ++k) if (s2 + k < nsplit) {
#pragma unroll
                    for (int j = 0; j < 4; ++j) v[j] = v[j] + t[k][j]; } }
        }
        float s = 0.f;
#pragma unroll
        for (int j = 0; j < 4; ++j) s += (v[j].x * v[j].x + v[j].y * v[j].y) + (v[j].z * v[j].z + v[j].w * v[j].w);
        const float rs = rsqrtf(wave_sum(s) * (1.f / DM) + EPS);
#pragma unroll
        for (int j = 0; j < 4; ++j) __builtin_nontemporal_store(v[j] * rs * gv[j], (f32x4*)(Y + (size_t)row * DM) + lane + 64 * j);
    }
}

#define MFMA32(a, b, c) __builtin_amdgcn_mfma_f32_32x32x16_bf16(a, b, c, 0, 0, 0)
#define MFMA16(a, b, c) __builtin_amdgcn_mfma_f32_16x16x32_bf16(a, b, c, 0, 0, 0)

__device__ __forceinline__ bf16x8 ld_vt(const bf16_t* p) {
    const u32x2 lo = *(const u32x2*)p, hi = *(const u32x2*)(p + 8);
    u32x4 t; t.x = lo.x; t.y = lo.y; t.z = hi.x; t.w = hi.y; return __builtin_bit_cast(bf16x8, t);
}
__device__ __forceinline__ bf16x8 pack8(const float* w) {
    u32x4 t; t.x = cvt_pk_bf16(w[0], w[1]); t.y = cvt_pk_bf16(w[2], w[3]); t.z = cvt_pk_bf16(w[4], w[5]); t.w = cvt_pk_bf16(w[6], w[7]); return __builtin_bit_cast(bf16x8, t);
}
__device__ __forceinline__ void store_ot(const f32x16& o0, const f32x16& o1, float sc, bf16_t* dst  , int hi) {
#pragma unroll
    for (int mt = 0; mt < 2; ++mt)
#pragma unroll
        for (int g = 0; g < 4; ++g) { const f32x16& o = mt ? o1 : o0; u32x2 w; w.x = cvt_pk_bf16(o[4 * g] * sc, o[4 * g + 1] * sc); w.y = cvt_pk_bf16(o[4 * g + 2] * sc, o[4 * g + 3] * sc);
            *(u32x2*)(dst + 32 * mt + 8 * g + 4 * hi) = w; }
}

__device__ __forceinline__ void sb_prompt_unit(const bf16_t* Z, const bf16_t* VT, bf16_t* CAT, LAS unsigned char* lds, int b, int h, int qb, int wave) {
    const int tid = opaque_tid(), lane = tid & 63;
    const int n = lane & 31, hi = lane >> 5;
    const int q0 = qb * 256 + wave * 32, qpos = q0 + n, ktd = q0 >> 5;
    const size_t rowb = (size_t)b * TP;
    bf16x8 bq[4];
#pragma unroll
    for (int s = 0; s < 4; ++s) bq[s] = *(const bf16x8*)(Z + (rowb + qpos) * NZ_AB + h * 64 + 16 * s + 8 * hi);
    f32x16 o0, o1;
#pragma unroll
    for (int r = 0; r < 16; ++r) { o0[r] = 0.f; o1[r] = 0.f; }
    float carry = 0.f; bool done = false;
    const int srow = tid >> 3, sseg = tid & 7, soff = srow * 144 + sseg * 16;
    const bf16_t* kgp = Z + (rowb + srow) * NZ_AB + 512 + h * 64 + sseg * 8;
    const bf16_t* vgp = VT + (size_t)(h * 64 + srow) * MP + rowb + sseg * 8;
    LAS int* dflag = (LAS int*)(lds + 36864);
    const int kc_first = 4 * qb + 3;
    u32x4 rk = *(const u32x4*)(kgp + (size_t)(kc_first * 64) * NZ_AB), rv = *(const u32x4*)(vgp + kc_first * 64);
    *(LAS u32x4*)(lds + soff) = rk; *(LAS u32x4*)(lds + 9216 + soff) = rv;
    __syncthreads();
    int buf = 0;
    for (int kc = kc_first; kc >= 0; --kc) {
        if (kc > 0) { rk = *(const u32x4*)(kgp + (size_t)((kc - 1) * 64) * NZ_AB); rv = *(const u32x4*)(vgp + (kc - 1) * 64); }
        const LAS unsigned char* kb = lds + buf * 18432; const LAS unsigned char* vb = kb + 9216;
#pragma unroll
        for (int half = 1; half >= 0; --half) {
            const int kt = 2 * kc + half;
            if (kt <= ktd && !done) {
                bf16x8 ak[4], av[2][2];
#pragma unroll
                for (int s = 0; s < 4; ++s) ak[s] = *(const LAS bf16x8*)(kb + (32 * half + n) * 144 + 32 * s + 16 * hi);
#pragma unroll
                for (int s2 = 0; s2 < 2; ++s2)
#pragma unroll
                    for (int mt = 0; mt < 2; ++mt) { const LAS unsigned char* p = vb + (32 * mt + n) * 144 + (32 * half + 16 * s2 + 4 * hi) * 2;
                        const u32x2 lo = *(const LAS u32x2*)p, hi2 = *(const LAS u32x2*)(p + 16); u32x4 t; t.x = lo.x; t.y = lo.y; t.z = hi2.x; t.w = hi2.y; av[s2][mt] = __builtin_bit_cast(bf16x8, t); }
                f32x16 st;
#pragma unroll
                for (int r = 0; r < 16; ++r) st[r] = 0.f;
#pragma unroll
                for (int s = 0; s < 4; ++s) st = MFMA32(ak[s], bq[s], st);
                const bool diag = (kt == ktd);
                float lb[16], lk[16];
#pragma unroll
                for (int r = 0; r < 16; ++r) { const float z2 = st[r] * 0.18033688f; const float l2 = fminf(z2, 0.f) - __builtin_amdgcn_logf(1.f + __builtin_amdgcn_exp2f(-fabsf(z2))); lb[r] = l2; lk[r] = l2 - z2; }
                if (diag) {
#pragma unroll
                    for (int r = 0; r < 16; ++r) { const int key = kt * 32 + crow(r, hi); if (key >= qpos) { lk[r] = 0.f; lb[r] = -1e30f; } }
                }
                float gs[4], pg[4];
#pragma unroll
                for (int g = 0; g < 4; ++g) { gs[g] = (lk[4 * g] + lk[4 * g + 1]) + (lk[4 * g + 2] + lk[4 * g + 3]); pg[g] = __shfl_xor(gs[g], 32); }
                float T[5]; T[4] = 0.f;
#pragma unroll
                for (int g = 3; g >= 0; --g) T[g] = T[g + 1] + (gs[g] + pg[g]);
                float w[16];
#pragma unroll
                for (int g = 0; g < 4; ++g) {
                    const float gsuf = carry + T[g + 1] + (hi == 0 ? pg[g] : 0.f);
                    const float e2 = lk[4 * g + 3], e1 = e2 + lk[4 * g + 2], e0 = e1 + lk[4 * g + 1];
                    const float af[4] = {gsuf + e0, gsuf + e1, gsuf + e2, gsuf};
#pragma unroll
                    for (int j = 0; j < 4; ++j) { const int r = 4 * g + j; w[r] = __builtin_amdgcn_exp2f(lb[r] + af[j]); }
                }
                carry += T[0];
#pragma unroll
                for (int s2 = 0; s2 < 2; ++s2) { const bf16x8 bw = pack8(w + 8 * s2); o0 = MFMA32(av[s2][0], bw, o0); o1 = MFMA32(av[s2][1], bw, o1); }
                if (SB_EARLY_EXIT && __all(carry < SB_EXIT_THR * 1.44269504f)) done = true;
            }
        }
        if (kc > 0) { const int nb = (buf ^ 1) * 18432; *(LAS u32x4*)(lds + nb + soff) = rk; *(LAS u32x4*)(lds + nb + 9216 + soff) = rv; }
        LAS int* df = dflag + (kc & 1) * 8;
        if (lane == 0) df[wave] = done ? 1 : 0;
        __syncthreads();
        const int alld = (df[0] & df[1]) & (df[2] & df[3]) & (df[4] & df[5]) & (df[6] & df[7]);
        if (alld) break;
        buf ^= 1;
    }
    store_ot(o0, o1, 1.f, CAT + (rowb + qpos) * DM + h * 64, hi);
}

__device__ __forceinline__ void band_prompt_unit(const bf16_t* Z, const bf16_t* VT, bf16_t* CAT, const LAS float* sbias, LAS unsigned char* lds, int b, int h, int qb, int wave) {
    const int tid = opaque_tid(), lane = tid & 63;
    const int n = lane & 31, hi = lane >> 5;
    const int c0 = qb * 4, cw = c0 + (wave >> 1);
    const int q0 = qb * 256 + wave * 32, qpos = q0 + n;
    const size_t rowb = (size_t)b * TP;
    bf16x8 bq[4];
#pragma unroll
    for (int s = 0; s < 4; ++s) bq[s] = *(const bf16x8*)(Z + (rowb + qpos) * NZ_C + h * 64 + 16 * s + 8 * hi);
    f32x16 o0, o1;
#pragma unroll
    for (int r = 0; r < 16; ++r) { o0[r] = 0.f; o1[r] = 0.f; }
    float mrun = -1e30f, lrun = 0.f;
    const int srow = tid >> 3, sseg = tid & 7, soff = srow * 144 + sseg * 16;
    const bf16_t* kgp = Z + (rowb + srow) * NZ_C + 1024 + h * 64 + sseg * 8;
    const bf16_t* vgp = VT + (size_t)(h * 64 + srow) * MP + rowb + sseg * 8;
    const int kc_first = (c0 >= 8) ? (c0 - 8) : 0, kc_last = c0 + 3;
    u32x4 rk = *(const u32x4*)(kgp + (size_t)(kc_first * 64) * NZ_C), rv = *(const u32x4*)(vgp + kc_first * 64);
    *(LAS u32x4*)(lds + soff) = rk; *(LAS u32x4*)(lds + 9216 + soff) = rv;
    __syncthreads();
    int buf = 0;
    for (int kc = kc_first; kc <= kc_last; ++kc) {
        if (kc < kc_last) { rk = *(const u32x4*)(kgp + (size_t)((kc + 1) * 64) * NZ_C); rv = *(const u32x4*)(vgp + (kc + 1) * 64); }
        if (kc >= cw - 8 && kc <= cw) {
            const LAS unsigned char* kb = lds + buf * 18432; const LAS unsigned char* vb = kb + 9216;
#pragma unroll
            for (int half = 0; half < 2; ++half) {
                const int kt = 2 * kc + half;
                bf16x8 ak[4], av[2][2];
#pragma unroll
                for (int s = 0; s < 4; ++s) ak[s] = *(const LAS bf16x8*)(kb + (32 * half + n) * 144 + 32 * s + 16 * hi);
#pragma unroll
                for (int s2 = 0; s2 < 2; ++s2)
#pragma unroll
                    for (int mt = 0; mt < 2; ++mt) { const LAS unsigned char* p = vb + (32 * mt + n) * 144 + (32 * half + 16 * s2 + 4 * hi) * 2;
                        const u32x2 lo = *(const LAS u32x2*)p, hi2 = *(const LAS u32x2*)(p + 16); u32x4 t; t.x = lo.x; t.y = lo.y; t.z = hi2.x; t.w = hi2.y; av[s2][mt] = __builtin_bit_cast(bf16x8, t); }
                f32x16 st;
#pragma unroll
                for (int r = 0; r < 16; ++r) st[r] = 0.f;
#pragma unroll
                for (int s = 0; s < 4; ++s) st = MFMA32(ak[s], bq[s], st);
                const LAS float* bp = sbias + (qpos + 63 - 27 - 4 * hi - 32 * kt);
                float sv[16]; float mx = -1e30f;
#pragma unroll
                for (int r = 0; r < 16; ++r) { sv[r] = st[r] * 0.18033688f + bp[27 - ((r & 3) + 8 * (r >> 2))]; mx = fmaxf(mx, sv[r]); }
                mx = fmaxf(mx, __shfl_xor(mx, 32));
                const float mnew = fmaxf(mrun, mx), alpha = __builtin_amdgcn_exp2f(mrun - mnew);
                float w[16]; float ps = 0.f;
#pragma unroll
                for (int r = 0; r < 16; ++r) { w[r] = __builtin_amdgcn_exp2f(sv[r] - mnew); ps += w[r]; }
                lrun = lrun * alpha + ps; mrun = mnew;
                if (!__all(alpha == 1.0f)) {
#pragma unroll
                    for (int r = 0; r < 16; ++r) { o0[r] *= alpha; o1[r] *= alpha; }
                }
#pragma unroll
                for (int s2 = 0; s2 < 2; ++s2) { const bf16x8 bw = pack8(w + 8 * s2); o0 = MFMA32(av[s2][0], bw, o0); o1 = MFMA32(av[s2][1], bw, o1); }
            }
        }
        if (kc < kc_last) { const int nb = (buf ^ 1) * 18432; *(LAS u32x4*)(lds + nb + soff) = rk; *(LAS u32x4*)(lds + nb + 9216 + soff) = rv; }
        __syncthreads();
        buf ^= 1;
    }
    const float l = lrun + __shfl_xor(lrun, 32);
    store_ot(o0, o1, 1.f / l, CAT + (rowb + qpos) * DM + h * 64, hi);
}

template <int MODE, int NQ>
__device__ __forceinline__ void sample_attn_item(const float* Kc, const float* Vc, int cstride, int npast, int t0,
                                                 const bf16_t* Zb  , int zstride, int qcol, int kcol, int vcol,
                                                 bf16_t* out  , const LAS float* sbias, LAS float* qs, LAS float* wb, int lane) {
    lane = opaque_tid() & 63;
#pragma unroll
    for (int t = 0; t < NQ; ++t) qs[t * 64 + lane] = bf2f(Zb[(size_t)(t0 + t) * zstride + qcol + lane]);
    LDS_WAIT();
    const int total = npast + 16, nblk = (total + 63) >> 6;
    float o[NQ], carry[NQ], mrun[NQ], lsum[NQ];
#pragma unroll
    for (int t = 0; t < NQ; ++t) { o[t] = 0.f; carry[t] = 0.f; mrun[t] = -1e30f; lsum[t] = 0.f; }
    for (int j = nblk - 1; j >= 0; --j) {
        const int kidx = 64 * j + lane; const bool vkey = kidx < total;
        const bool past = 64 * j < npast;
        const int nk = (total - 64 * j) < 64 ? (total - 64 * j) : 64;
        float kr[64];
        float vv[16];
        if (past) {
            const f32x4* p = (const f32x4*)(Kc + (size_t)kidx * cstride);
#pragma unroll
            for (int i = 0; i < 16; ++i) { const f32x4 v = p[i]; kr[4 * i] = v.x; kr[4 * i + 1] = v.y; kr[4 * i + 2] = v.z; kr[4 * i + 3] = v.w; }
            const float* vp = Vc + (size_t)(64 * j) * cstride + lane;
#pragma unroll
            for (int i = 0; i < 16; ++i) vv[i] = __builtin_nontemporal_load(vp + (size_t)i * cstride);
        } else {
            const int tt = vkey ? (kidx - npast) : 0;
            const u32x4* p = (const u32x4*)(Zb + (size_t)tt * zstride + kcol);
#pragma unroll
            for (int i = 0; i < 8; ++i) { const u32x4 v = p[i]; kr[8 * i] = bflo(v.x); kr[8 * i + 1] = bfhi(v.x); kr[8 * i + 2] = bflo(v.y); kr[8 * i + 3] = bfhi(v.y);
                kr[8 * i + 4] = bflo(v.z); kr[8 * i + 5] = bfhi(v.z); kr[8 * i + 6] = bflo(v.w); kr[8 * i + 7] = bfhi(v.w); }
#pragma unroll
            for (int i = 0; i < 16; ++i) vv[i] = bf2f(Zb[(size_t)i * zstride + vcol + lane]);
        }
#pragma unroll
        for (int t = 0; t < NQ; ++t) {
            float z = 0.f;
#pragma unroll
            for (int i = 0; i < 16; ++i) { const f32x4 qv = *(const LAS f32x4*)(qs + t * 64 + 4 * i); z += qv.x * kr[4 * i] + qv.y * kr[4 * i + 1] + qv.z * kr[4 * i + 2] + qv.w * kr[4 * i + 3]; }
            z *= 0.125f;
            float wv;
            if (MODE == 0) {
                const bool valid = vkey && (kidx < npast + t0 + t);
                const float lbv = log_sigmoid_f(z); const float lkv = valid ? (lbv - z) : 0.f;
                float x = lkv;
#pragma unroll
                for (int off = 1; off < 64; off <<= 1) { const float y = __shfl_down(x, off); if (lane + off < 64) x += y; }
                wv = valid ? __expf(lbv + carry[t] + (x - lkv)) : 0.f;
                carry[t] += __shfl(x, 0);
            } else {
                int rel = npast + t0 + t - kidx; rel = rel > 128 ? 128 : rel; rel = rel < -63 ? -63 : rel;
                const float s = vkey ? (z + sbias[rel + 63]) : -1e30f;
                const float mnew = fmaxf(mrun[t], wave_max(s)), alpha = __expf(mrun[t] - mnew);
                wv = vkey ? __expf(s - mnew) : 0.f;
                lsum[t] = lsum[t] * alpha + wv; o[t] *= alpha; mrun[t] = mnew;
            }
            wb[lane * NQ + t] = wv;
        }
        LDS_WAIT();
        for (int k0 = 0; k0 < nk; k0 += 16) {
            float vn[16];
            if (past && k0 + 16 < nk) { const float* vp = Vc + (size_t)(64 * j + k0 + 16) * cstride + lane;
#pragma unroll
                for (int i = 0; i < 16; ++i) vn[i] = __builtin_nontemporal_load(vp + (size_t)i * cstride); }
            else {
#pragma unroll
                for (int i = 0; i < 16; ++i) vn[i] = 0.f; }
#pragma unroll
            for (int i = 0; i < 16; ++i) {
#pragma unroll
                for (int t = 0; t < NQ; ++t) o[t] += wb[(k0 + i) * NQ + t] * vv[i];
            }
#pragma unroll
            for (int i = 0; i < 16; ++i) vv[i] = vn[i];
        }
        LDS_WAIT();
        if (MODE == 0 && SB_EARLY_EXIT) {
            bool done = true;
#pragma unroll
            for (int t = 0; t < NQ; ++t) done = done && (carry[t] < SB_EXIT_THR);
            if (done) break;
        }
    }
#pragma unroll
    for (int t = 0; t < NQ; ++t) {
        float val = o[t];
        if (MODE == 1) val = val / wave_sum(lsum[t]);
        out[(size_t)(t0 + t) * DM + lane] = f2bf(val);
    }
}

struct GlaWs { float* UTp; float* UTs; float* OI; bf16_t* SPT; bf16_t* QG; float* Dg; };
__device__ __forceinline__ float* gla_ut(const GlaWs& W, int ug) { return ug < 1024 ? W.UTp + (size_t)ug * 8192 : W.UTs + (size_t)(ug - 1024) * 8192; }
__device__ __forceinline__ void gla_stage1(const bf16_t* Z, const bf16_t* VT, const float* wgate, const float* bgate, const GlaWs& W, int ug, int par, LAS unsigned char* lds) {
    LAS unsigned char* base = lds + par * 36864;
    LAS bf16_t* qg = (LAS bf16_t*)(base);
    LAS bf16_t* kg = (LAS bf16_t*)(base + 9216);
    LAS bf16_t* kdT = (LAS bf16_t*)(base + 18432);
    LAS bf16_t* att = (LAS bf16_t*)(base + 27648);
    const int tid = opaque_tid(), lane = tid & 63, w = __builtin_amdgcn_readfirstlane(tid >> 6), l16 = lane & 15, q4 = lane >> 4;
    int h, nvalid; size_t row0;
    if (ug < 1024) { const int bh = ug >> 5, c = ug & 31; h = bh & 3; row0 = (size_t)(bh >> 2) * TP + 64 * c; nvalid = 64; }
    else { const int bh = ug - 1024; h = bh & 3; row0 = (size_t)MPROMPT + (bh >> 2) * TSAMP; nvalid = 16; }
    const bool valid = lane < nvalid;
    const bf16_t* zr = Z + (row0 + (valid ? lane : 0)) * NZ_AB;
    const u32x4 g0 = *(const u32x4*)(zr + 3072), g1 = *(const u32x4*)(zr + 3080);
    const u32x4 q8 = *(const u32x4*)(zr + 1536 + h * 64 + 8 * w), k8 = *(const u32x4*)(zr + 1792 + h * 64 + 8 * w);
    bf16x8 vt[2];
#pragma unroll
    for (int ks = 0; ks < 2; ++ks) vt[ks] = *(const bf16x8*)(VT + (size_t)(512 + h * 128 + 16 * w + l16) * MP + row0 + 32 * ks + 8 * q4);
    float gl[16];
    gl[0] = bflo(g0.x); gl[1] = bfhi(g0.x); gl[2] = bflo(g0.y); gl[3] = bfhi(g0.y); gl[4] = bflo(g0.z); gl[5] = bfhi(g0.z); gl[6] = bflo(g0.w); gl[7] = bfhi(g0.w);
    gl[8] = bflo(g1.x); gl[9] = bfhi(g1.x); gl[10] = bflo(g1.y); gl[11] = bfhi(g1.y); gl[12] = bflo(g1.z); gl[13] = bfhi(g1.z); gl[14] = bflo(g1.w); gl[15] = bfhi(g1.w);
    float bb[8], tot[8];
    {
        const float* wgp = wgate + h * 64 + 8 * w; const float* bgp = bgate + h * 64 + 8 * w;
        float pre[8];
#pragma unroll
        for (int e = 0; e < 8; ++e) pre[e] = bgp[e];
#pragma unroll
        for (int j = 0; j < 16; ++j)
#pragma unroll
            for (int e = 0; e < 8; ++e) pre[e] += gl[j] * wgp[j * 256 + e];
#pragma unroll
        for (int e = 0; e < 8; ++e) {
            float x = valid ? log_sigmoid_f(pre[e]) * (1.f / 16.f) : 0.f;
#pragma unroll
            for (int off = 1; off < 64; off <<= 1) { const float y = __shfl_up(x, off); if (lane >= off) x += y; }
            bb[e] = x; tot[e] = __shfl(x, 63);
        }
    }
    {
        const float qf[8] = {bflo(q8.x), bfhi(q8.x), bflo(q8.y), bfhi(q8.y), bflo(q8.z), bfhi(q8.z), bflo(q8.w), bfhi(q8.w)};
        const float kf[8] = {bflo(k8.x), bfhi(k8.x), bflo(k8.y), bfhi(k8.y), bflo(k8.z), bfhi(k8.z), bflo(k8.w), bfhi(k8.w)};
        float qo[8], ko[8];
#pragma unroll
        for (int e = 0; e < 8; ++e) { const float qv = valid ? qf[e] : 0.f, kv = valid ? kf[e] : 0.f; qo[e] = qv * 0.125f * __expf(bb[e]); ko[e] = kv * __expf(-bb[e]);
            kdT[(8 * w + e) * 72 + lane] = f2bf(kv * __expf(tot[e] - bb[e])); }
        u32x4 qp, kp; qp.x = cvt_pk_bf16(qo[0], qo[1]); qp.y = cvt_pk_bf16(qo[2], qo[3]); qp.z = cvt_pk_bf16(qo[4], qo[5]); qp.w = cvt_pk_bf16(qo[6], qo[7]);
        kp.x = cvt_pk_bf16(ko[0], ko[1]); kp.y = cvt_pk_bf16(ko[2], ko[3]); kp.z = cvt_pk_bf16(ko[4], ko[5]); kp.w = cvt_pk_bf16(ko[6], ko[7]);
        *(LAS u32x4*)(qg + lane * 72 + 8 * w) = qp; *(LAS u32x4*)(kg + lane * 72 + 8 * w) = kp;
        *(u32x4*)(W.QG + (size_t)ug * 4096 + lane * 64 + 8 * w) = qp;
        if (lane == 63) { float* dp = W.Dg + (size_t)ug * 64 + 8 * w;
#pragma unroll
            for (int e = 0; e < 8; ++e) dp[e] = tot[e]; }
    }
    __syncthreads();
    {
        const int rt = w >> 1;
#pragma unroll
        for (int cc = 0; cc < 2; ++cc) { const int ct = 2 * (w & 1) + cc; f32x4 acc = (f32x4){0.f, 0.f, 0.f, 0.f};
#pragma unroll
            for (int ks = 0; ks < 2; ++ks) { const bf16x8 A = *(const LAS bf16x8*)(qg + (16 * rt + l16) * 72 + 32 * ks + 8 * q4), B = *(const LAS bf16x8*)(kg + (16 * ct + l16) * 72 + 32 * ks + 8 * q4); acc = MFMA16(A, B, acc); }
#pragma unroll
            for (int r = 0; r < 4; ++r) { const int t = 16 * rt + 4 * q4 + r, s2 = 16 * ct + l16; att[t * 72 + s2] = f2bf(s2 <= t ? acc[r] : 0.f); } }
    }
    __syncthreads();
    {
        float* oi = W.OI + (size_t)ug * 8192 + tid;
#pragma unroll
        for (int rt = 0; rt < 4; ++rt) { f32x4 o = (f32x4){0.f, 0.f, 0.f, 0.f};
#pragma unroll
            for (int ks = 0; ks < 2; ++ks) { const bf16x8 A1 = *(const LAS bf16x8*)(att + (16 * rt + l16) * 72 + 32 * ks + 8 * q4); o = MFMA16(A1, vt[ks], o); }
#pragma unroll
            for (int r = 0; r < 4; ++r) oi[(rt * 4 + r) * 512] = o[r]; }
        float* ut = gla_ut(W, ug);
#pragma unroll
        for (int ct = 0; ct < 4; ++ct) { f32x4 u = (f32x4){0.f, 0.f, 0.f, 0.f};
#pragma unroll
            for (int ks = 0; ks < 2; ++ks) { const bf16x8 Bk = *(const LAS bf16x8*)(kdT + (16 * ct + l16) * 72 + 32 * ks + 8 * q4); u = MFMA16(vt[ks], Bk, u); }
#pragma unroll
            for (int r = 0; r < 4; ++r) ut[(16 * w + 4 * q4 + r) * 64 + 16 * ct + l16] = u[r]; }
    }
}
__device__ __forceinline__ void gla_scan(const GlaWs& W, const float* state_in, float* bsp, float* bss, int gt, int NT) {
    for (int item = gt; item < 64 * 8192; item += NT) {
        const int bh64 = item >> 13, e = item & 8191, dk = e & 63, dv = e >> 6;
        if (bh64 < 32) {
            float uu[32], dd[32];
#pragma unroll
            for (int c = 0; c < 32; ++c) { const int ug = bh64 * 32 + c; uu[c] = __builtin_nontemporal_load(W.UTp + (size_t)ug * 8192 + e); dd[c] = W.Dg[(size_t)ug * 64 + dk]; }
            float S = 0.f;
#pragma unroll
            for (int c = 0; c < 32; ++c) { const int ug = bh64 * 32 + c; W.SPT[(size_t)ug * 8192 + e] = f2bf(S); S = __expf(dd[c]) * S + uu[c]; }
            bsp[(size_t)bh64 * 8192 + dk * 128 + dv] = S;
        } else {
            const int bh = bh64 - 32, ug = 1024 + bh; const float S0 = state_in[(size_t)bh * 8192 + dk * 128 + dv];
            W.SPT[(size_t)ug * 8192 + e] = f2bf(S0);
            bss[(size_t)bh * 8192 + dk * 128 + dv] = __expf(W.Dg[(size_t)ug * 64 + dk]) * S0 + W.UTs[(size_t)bh * 8192 + e];
        }
    }
}
__device__ __forceinline__ void gla_stage3_item(const bf16_t* Z, bf16_t* CAT, const float* ggla, const GlaWs& W, int ug, int rt) {
    const int lane = opaque_tid() & 63, l16 = lane & 15, q4 = lane >> 4;
    int h, nvalid; size_t row0;
    if (ug < 1024) { const int bh = ug >> 5, c = ug & 31; h = bh & 3; row0 = (size_t)(bh >> 2) * TP + 64 * c; nvalid = 64; }
    else { const int bh = ug - 1024; h = bh & 3; row0 = (size_t)MPROMPT + (bh >> 2) * TSAMP; nvalid = 16; }
    if (16 * rt >= nvalid) return;
    const float* oi = W.OI + (size_t)ug * 8192 + (rt * 4) * 512 + lane;
    f32x4 o[8];
#pragma unroll
    for (int w = 0; w < 8; ++w)
#pragma unroll
        for (int r = 0; r < 4; ++r) o[w][r] = __builtin_nontemporal_load(oi + r * 512 + w * 64);
    bf16x8 A2[2];
#pragma unroll
    for (int ks = 0; ks < 2; ++ks) A2[ks] = *(const bf16x8*)(W.QG + (size_t)ug * 4096 + (16 * rt + l16) * 64 + 32 * ks + 8 * q4);
    float rr[8][4];
#pragma unroll
    for (int w = 0; w < 8; ++w)
#pragma unroll
        for (int r = 0; r < 4; ++r) rr[w][r] = bf2f(Z[(row0 + 16 * rt + 4 * q4 + r) * NZ_AB + 2560 + h * 128 + 16 * w + l16]);
#pragma unroll
    for (int w = 0; w < 8; ++w)
#pragma unroll
        for (int ks = 0; ks < 2; ++ks) { const bf16x8 B2 = *(const bf16x8*)(W.SPT + (size_t)ug * 8192 + (16 * w + l16) * 64 + 32 * ks + 8 * q4); o[w] = MFMA16(A2[ks], B2, o[w]); }
    float rstd[4];
#pragma unroll
    for (int r = 0; r < 4; ++r) { float ss = 0.f;
#pragma unroll
        for (int w = 0; w < 8; ++w) ss += o[w][r] * o[w][r];
        ss += __shfl_xor(ss, 1); ss += __shfl_xor(ss, 2); ss += __shfl_xor(ss, 4); ss += __shfl_xor(ss, 8);
        rstd[r] = rsqrtf(ss * (1.f / 128.f) + EPS); }
#pragma unroll
    for (int w = 0; w < 8; ++w) { const float gg = ggla[h * 128 + 16 * w + l16];
#pragma unroll
        for (int r = 0; r < 4; ++r) { const float rv = rr[w][r];
            CAT[(row0 + 16 * rt + 4 * q4 + r) * DM + 512 + h * 128 + 16 * w + l16] = f2bf(o[w][r] * rstd[r] * gg * rv * __builtin_amdgcn_rcpf(1.f + __expf(-rv))); } }
}

#define XB_TMO      128
#define XB_XCNT(j)  (256  + 64 * (j))
#define XB_XSUB(j)  (1280 + 64 * (j))
#define XB_XGEN(j)  (2304 + 64 * (j))
#define XB_TOP      3328
#define XB_TOPGEN   3392
#define XCD_BAR_WORDS 3456
#define XB_SPIN_CAP (1u << 22)
__device__ __forceinline__ unsigned xb_ld(unsigned* p)              { return __hip_atomic_load(p, __ATOMIC_RELAXED, __HIP_MEMORY_SCOPE_AGENT); }
__device__ __forceinline__ unsigned xb_add(unsigned* p, unsigned v) { return __hip_atomic_fetch_add(p, v, __ATOMIC_RELAXED, __HIP_MEMORY_SCOPE_AGENT); }
__device__ __forceinline__ unsigned xb_xcc_id() { return (unsigned)__builtin_amdgcn_s_getreg((3 << 11) | 20) & 0xFu; }
#define XB_SPIN(cond, bar) do { unsigned _sp = 0; while (cond) { __builtin_amdgcn_s_sleep(1); \
    if ((++_sp & 255u) == 0u) { if (xb_ld(&(bar)[XB_TMO])) break; if (_sp > XB_SPIN_CAP) { atomicAdd(&(bar)[XB_TMO], 1u); break; } } } } while (0)
struct XcdBarrier { unsigned* bar; unsigned x; volatile LAS unsigned* st; };
__device__ __forceinline__ XcdBarrier xcd_barrier_post(unsigned* bar, volatile LAS unsigned* st) {
    XcdBarrier b; b.bar = bar; b.x = xb_xcc_id(); b.st = st;
    if (opaque_tid() == 0) (void)xb_add(&bar[XB_XCNT(b.x)], 1u);
    return b;
}
__device__ __forceinline__ void xcd_barrier_complete(unsigned* bar, unsigned x, unsigned& nloc, unsigned& nx) {
    const unsigned G = gridDim.x * gridDim.y * gridDim.z;
    unsigned sum, cnt, mine, sp = 0u;
    for (;;) {
        sum = 0u; cnt = 0u; mine = 0u;
#pragma unroll
        for (unsigned j = 0; j < 16; ++j) { const unsigned c = xb_ld(&bar[XB_XCNT(j)]); sum += c; cnt += (c > 0u) ? 1u : 0u; mine = (j == x) ? c : mine; }
        if (sum == G) break;
        __builtin_amdgcn_s_sleep(1);
        if ((++sp & 255u) == 0u) { if (xb_ld(&bar[XB_TMO])) break; if (sp > XB_SPIN_CAP) { atomicAdd(&bar[XB_TMO], 1u); break; } }
    }
    nloc = mine > 0u ? mine : 1u; nx = cnt > 0u ? cnt : 1u;
}
__device__ __forceinline__ void xcd_barrier(const XcdBarrier& b) {
    asm volatile("s_waitcnt vmcnt(0)" ::: "memory");
    __syncthreads();
    if (opaque_tid() == 0) {
        unsigned* bar = b.bar;
        __builtin_amdgcn_s_waitcnt(0);
        unsigned nloc = b.st[0], nx = b.st[1];
        if (nloc == 0u) { xcd_barrier_complete(bar, b.x, nloc, nx); b.st[0] = nloc; b.st[1] = nx; }
        const unsigned old = xb_add(&bar[XB_XSUB(b.x)], 1u);
        const unsigned gen = old / nloc;
        if (old + 1u == (gen + 1u) * nloc) {
            __builtin_amdgcn_fence(__ATOMIC_RELEASE, "agent");
            asm volatile("s_waitcnt vmcnt(0)" ::: "memory");
            const unsigned og = xb_add(&bar[XB_TOP], 1u);
            const unsigned tg = og / nx;
            if (og + 1u == (tg + 1u) * nx) xb_add(&bar[XB_TOPGEN], 1u);
            else XB_SPIN(xb_ld(&bar[XB_TOPGEN]) == tg, bar);
            __builtin_amdgcn_fence(__ATOMIC_ACQUIRE, "agent");
            xb_add(&bar[XB_XGEN(b.x)], 1u);
            asm volatile("s_waitcnt vmcnt(0)" ::: "memory");
        } else {
            XB_SPIN(xb_ld(&bar[XB_XGEN(b.x)]) == gen, bar);
            __builtin_amdgcn_fence(__ATOMIC_ACQUIRE, "agent");
            asm volatile("s_waitcnt vmcnt(0)" ::: "memory");
        }
    }
    __syncthreads();
}

constexpr int LDS_SLOT = 131072;
constexpr int LDS_BIAS = 131072 + 256;
__device__ __forceinline__ int next_unit(unsigned* ctr, LAS int* slot) {
    __syncthreads();
    if (opaque_tid() == 0) *slot = (int)atomicAdd(ctr, 1u);
    __syncthreads();
    return *slot;
}

__global__ void __launch_bounds__(512, 2) fwd_megakernel(Args a_unused) {
    extern __shared__ __attribute__((aligned(16))) unsigned char lds_raw[];
    LAS unsigned char* lds = (LAS unsigned char*)lds_raw;
    cg::grid_group grid = cg::this_grid();
    const int tid = opaque_tid(), lane = tid & 63, wave = __builtin_amdgcn_readfirstlane(tid >> 6);
    const int G = gridDim.x, gw = blockIdx.x * 8 + wave, NGW = G * 8;
#define PHASE_ARGS() const CAS4 Args& a = fresh_args(); unsigned char* ws = a.ws; unsigned* ctr = (unsigned*)(ws + WS_CTL); float* X = (float*)(ws + WS_X); bf16_t* H = (bf16_t*)(ws + WS_H); \
    bf16_t* Z = (bf16_t*)(ws + WS_Z); bf16_t* Gh = (bf16_t*)(ws + WS_Z); bf16_t* CAT = (bf16_t*)(ws + WS_CAT); bf16_t* VT = (bf16_t*)(ws + WS_VT); \
    (void)ctr; (void)X; (void)H; (void)Z; (void)Gh; (void)CAT; (void)VT
    LAS int* slot = (LAS int*)(lds + LDS_SLOT);
    LAS float* sbias = (LAS float*)(lds + LDS_BIAS);

    unsigned* barw;
    volatile LAS unsigned* bst = (volatile LAS unsigned*)(lds + LDS_SLOT + 16);
    {
    PHASE_ARGS();
    barw = ctr + 8192;
    if (tid < 2) bst[tid] = 0u;
    if (blockIdx.x == 0) { if (tid < 64) ctr[tid * 64] = 0u; for (int i = tid; i < XCD_BAR_WORDS; i += 512) barw[i] = 0u; }
    prologue_weights(a, lds, gw, NGW, wave, lane);
    norm_phase(a.in[I_XP], a.in[I_XS], X, a.in[I_GMIX], H, nullptr, 0, true, gw, NGW, lane);
    }
    grid.sync();
    const XcdBarrier xbar = xcd_barrier_post(barw, bst);
#define GRID_BAR() xcd_barrier(xbar)

#pragma nounroll
    for (int layer = 0; layer < 4; ++layer) {
        const int li = layer >> 1;
        if (layer > 0) { PHASE_ARGS(); norm_phase(nullptr, nullptr, X, a.in[I_GMIX] + layer * DM, H, (const float*)(ws + WS_PART), 11, false, gw, NGW, lane); GRID_BAR(); }
        if ((layer & 1) == 0) {
            {
                PHASE_ARGS();
                pg8::Gemm g{H, (const bf16_t*)(ws + WS_WIN + li * SZ_WIN), MP, NZ_AB, DM}; pg8::StaticOrder S; S.init(MPROMPT, NZ_AB, DM, 1, G, (int)blockIdx.x);
                EpiInAB E{Z, VT, a.out + O_AKP + (size_t)li * MPROMPT * 512, a.out + O_AVP + (size_t)li * MPROMPT * 512, a.out + O_AKS + (size_t)li * MSAMP * 512, a.out + O_AVS + (size_t)li * MSAMP * 512};
                pg8::gemm_phase<EpiInAB>(lds, g, S, E);
            }
            GRID_BAR();
            for (int rep = 0; rep <= REP_MIX_AB; ++rep) {
                PHASE_ARGS();
                const int shard = (int)blockIdx.x & 7;
                unsigned* c = ctr + 64 * (layer * 8); (void)rep; (void)shard;
                const float* wgate = a.in[I_WGATE] + (size_t)li * 16 * 256; const float* bgate = a.in[I_BGATE] + li * 256; const float* ggla = a.in[I_GGLA] + li * 512;
                const GlaWs W{(float*)(ws + WS_H), (float*)(ws + WS_GLA_UTS), (float*)(ws + WS_GLA_OI), (bf16_t*)(ws + WS_GLA_SPT), (bf16_t*)(ws + WS_GLA_QG), (float*)(ws + WS_GLA_D)};
                { int par = 0; for (int ug = blockIdx.x; ug < 1056; ug += G, par ^= 1) gla_stage1(Z, VT, wgate, bgate, W, ug, par, lds); }
                for (;;) {
                    const int tk = next_unit(c, slot);
                    if (tk >= 544) break;
                    const int u = tk;
                    if (u < 32) { const int it = u * 8 + wave, bh = it >> 2, b = bh >> 3, h = bh & 7, t0 = (it & 3) * 4;
                        const size_t cb = ((size_t)(li * NB + b) * PAST) * 512 + h * 64;
                        sample_attn_item<0, 4>(a.in[I_CAK] + cb, a.in[I_CAV] + cb, 512, PAST, t0, Z + (size_t)(MPROMPT + b * TSAMP) * NZ_AB, NZ_AB, h * 64, 512 + h * 64, 1024 + h * 64,
                                            CAT + (size_t)(MPROMPT + b * TSAMP) * DM + h * 64, sbias, (LAS float*)(lds + wave * 16384), (LAS float*)(lds + wave * 16384 + 4096), lane);
                    } else { const int v = u - 32, qb = 7 - (v >> 6), bh = v & 63;
                        sb_prompt_unit(Z, VT, CAT, lds, bh >> 3, bh & 7, qb, wave);
                    }
                }
                GRID_BAR();
                gla_scan(W, a.in[I_SB] + (size_t)li * 32 * 8192, a.out + O_BSP + (size_t)li * 32 * 8192, a.out + O_BSS + (size_t)li * 32 * 8192, (int)blockIdx.x * 512 + opaque_tid(), G * 512);
                GRID_BAR();
                for (int it = gw; it < 1056 * 4; it += NGW) gla_stage3_item(Z, CAT, ggla, W, it >> 2, it & 3);
                if (rep < REP_MIX_AB) GRID_BAR();
            }
            GRID_BAR();
            {
                PHASE_ARGS();
                pg8::Gemm g{CAT, (const bf16_t*)(ws + WS_WOAB + li * SZ_WO), MP, DM, DM}; pg8::StaticOrder S; S.init(MPROMPT, DM, DM, 4, G, (int)blockIdx.x);
                EpiResid E{X, (float*)(ws + WS_PART)}; pg8::gemm_phase<EpiResid>(lds, g, S, E);
            }
            GRID_BAR();
        } else {
            {
                PHASE_ARGS();
                pg8::Gemm g{H, (const bf16_t*)(ws + WS_WQKV + li * SZ_WQKV), MP, NZ_C, DM}; pg8::StaticOrder S; S.init(MPROMPT, NZ_C, DM, 1, G, (int)blockIdx.x);
                EpiInC E{Z, VT, a.out + O_CKP + (size_t)li * NB * CWIN * 1024, a.out + O_CVP + (size_t)li * NB * CWIN * 1024, a.out + O_CKS + (size_t)li * MSAMP * 1024, a.out + O_CVS + (size_t)li * MSAMP * 1024};
                pg8::gemm_phase<EpiInC>(lds, g, S, E);
            }
            GRID_BAR();
            for (int rep = 0; rep <= REP_MIX_C; ++rep) {
                PHASE_ARGS();
                const int shard = (int)blockIdx.x & 7;
                unsigned* c = ctr + 64 * (layer * 8 + shard); (void)rep;
                const float* rel = a.in[I_REL] + (size_t)li * 16 * 192;
                for (;;) {
                    const int tk = next_unit(c, slot);
                    if (tk >= 136) break;
                    const int u = tk < 8 ? tk * 8 + shard : 64;
                    if (u >= 64) { const int v = tk - 8;
                        const int qb = v < 96 ? 2 + v % 6 : (v < 112 ? 1 : 0), bh = (v < 96 ? v / 6 : (v < 112 ? v - 96 : v - 112)) * 8 + shard, b = bh >> 4, h = bh & 15;
                        { const int t2 = opaque_tid(); for (int i = t2; i < 768; i += 512) sbias[i] = rel[h * 192 + (i < 191 ? i : 191)] * 1.44269504f; }
                        __syncthreads();
                        band_prompt_unit(Z, VT, CAT, sbias, lds, b, h, qb, wave);
                    } else { const int it = u * 8 + wave, bh = it >> 2, b = bh >> 4, h = bh & 15, t0 = (it & 3) * 4;
                        LAS float* wbias = (LAS float*)(lds + wave * 16384 + 12288);
                        { const int l2 = opaque_tid() & 63; for (int i = l2; i < 192; i += 64) wbias[i] = rel[h * 192 + i]; }
                        LDS_WAIT();
                        const size_t cb = ((size_t)(li * NB + b) * CWIN) * 1024 + h * 64;
                        sample_attn_item<1, 4>(a.in[I_CCK] + cb, a.in[I_CCV] + cb, 1024, CWIN, t0, Z + (size_t)(MPROMPT + b * TSAMP) * NZ_C, NZ_C, h * 64, 1024 + h * 64, 2048 + h * 64,
                                            CAT + (size_t)(MPROMPT + b * TSAMP) * DM + h * 64, wbias, (LAS float*)(lds + wave * 16384), (LAS float*)(lds + wave * 16384 + 4096), lane);
                    }
                }
                if (rep < REP_MIX_C) GRID_BAR();
            }
            GRID_BAR();
            {
                PHASE_ARGS();
                pg8::Gemm g{CAT, (const bf16_t*)(ws + WS_WOC + li * SZ_WO), MP, DM, DM}; pg8::StaticOrder S; S.init(MPROMPT, DM, DM, 4, G, (int)blockIdx.x);
                EpiResid E{X, (float*)(ws + WS_PART)}; pg8::gemm_phase<EpiResid>(lds, g, S, E);
            }
            GRID_BAR();
        }
        { PHASE_ARGS(); norm_phase(nullptr, nullptr, X, a.in[I_GFFN] + layer * DM, H, (const float*)(ws + WS_PART), 4, false, gw, NGW, lane); }
        GRID_BAR();
        {
            PHASE_ARGS();
            pg8::Gemm g{H, (const bf16_t*)(ws + WS_WGU + layer * SZ_WGU), MP, NGU, DM}; pg8::StaticOrder S; S.init(MPROMPT, NGU, DM, 1, G, (int)blockIdx.x);
            EpiSwiglu E{Gh};
            for (int rep = 0; rep <= REP_UP; ++rep) { pg8::gemm_phase<EpiSwiglu>(lds, g, S, E); if (rep < REP_UP) GRID_BAR(); }
        }
        GRID_BAR();
        {
            PHASE_ARGS();
            pg8::Gemm g{Gh, (const bf16_t*)(ws + WS_WD + layer * SZ_WD), MP, DM, DFF}; pg8::StaticOrder S; S.init(MPROMPT, DM, DFF, 11, G, (int)blockIdx.x);
            EpiResid E{X, (float*)(ws + WS_PART)}; pg8::gemm_phase<EpiResid>(lds, g, S, E);
        }
        GRID_BAR();
    }
    { PHASE_ARGS(); final_norm_phase(X, a.in[I_GFIN], a.out + O_YP, (const float*)(ws + WS_PART), 11, gw, NGW, lane); }
}

extern "C" void kernel_launch(void* const* d_in, const int* in_sizes, int n_in, void* d_out, int out_size, void* d_ws, size_t ws_size, hipStream_t stream) {
    static int grid = 0;
    if (grid == 0) {
        if (n_in != 21 || (size_t)out_size != O_END || ws_size < WS_END) { fprintf(stderr, "kernel_launch: unexpected shapes (n_in %d, out %d vs %zu, ws %zu vs %zu)\n", n_in, out_size, (size_t)O_END, ws_size, (size_t)WS_END); grid = -1; return; }
        int dev = 0, cus = 0, per_cu = 0;
        hipGetDevice(&dev); hipDeviceGetAttribute(&cus, hipDeviceAttributeMultiprocessorCount, dev);
        if (hipFuncSetAttribute((const void*)fwd_megakernel, hipFuncAttributeMaxDynamicSharedMemorySize, LDS_BYTES) != hipSuccess) { fprintf(stderr, "kernel_launch: hipFuncSetAttribute failed\n"); grid = -1; return; }
        if (hipOccupancyMaxActiveBlocksPerMultiprocessor(&per_cu, (const void*)fwd_megakernel, 512, LDS_BYTES) != hipSuccess || per_cu < 1) { fprintf(stderr, "kernel_launch: occupancy query says %d\n", per_cu); per_cu = 1; }
        (void)hipGetLastError();
        grid = cus * per_cu;
    }
    if (grid < 0) return;
    Args a{};
    for (int i = 0; i < 21; ++i) a.in[i] = (const float*)d_in[i];
    a.out = (float*)d_out; a.ws = (unsigned char*)d_ws;
    void* args[] = {&a};
    hipError_t e = hipLaunchCooperativeKernel((const void*)fwd_megakernel, dim3(grid), dim3(512), args, LDS_BYTES, stream);
    if (e != hipSuccess) fprintf(stderr, "cooperative launch failed: %s (grid %d)\n", hipGetErrorString(e), grid);
}
```
